# Optimizing an MI355X kernel written in HIP

```python
import math
import jax, jax.numpy as jnp
from jax import lax
import numpy as np

D_MODEL = 1024
BATCH = 4
SEQ = 4096
DEPTH = 2

MEM_LEN = 256
N_AB = (DEPTH + 1) // 2
N_CD = DEPTH // 2
MIX_W = D_MODEL // 2
NORM_EPS = 1e-6
N_NORMS = 7

GLA_HEADS = 4
GLA_DV = MIX_W // GLA_HEADS
GLA_DK = GLA_DV // 2
GLA_RANK = 16
GLA_TAU = 16.0
GLA_CHUNK = 64

S5_GROUP = 16
S5_GROUPS = MIX_W // S5_GROUP
S5_STATE = 64

RWKV_HEAD = 64
RWKV_HEADS = MIX_W // RWKV_HEAD
RWKV_DECAY_RANK = 64
RWKV_A_RANK = 64
RWKV_GATE_RANK = 128
RWKV_GN_EPS = 64e-5

LRU_BLOCKS = 8
LRU_BLOCK = MIX_W // LRU_BLOCKS
LRU_CONV = 4
LRU_C = 8.0

XA_HEADS = 4
XA_HEAD_DIM = D_MODEL // XA_HEADS
D_FF = 4 * D_MODEL

AB_SIZES = (GLA_HEADS * GLA_DK, GLA_HEADS * GLA_DK, MIX_W, MIX_W, GLA_RANK, MIX_W)
AB_COLS = sum(AB_SIZES)
RWKV_SIZES = (MIX_W, RWKV_DECAY_RANK, MIX_W, MIX_W, RWKV_A_RANK, RWKV_GATE_RANK)
RWKV_COLS = sum(RWKV_SIZES)
CD_SIZES = (RWKV_COLS, MIX_W, MIX_W)
CD_COLS = sum(CD_SIZES)

kernel_name = 'hybrid_gla_s5_rwkv7_rglru_trunk'


def _split(p, sizes):
    return jnp.split(p, [int(s) for s in np.cumsum(sizes)[:-1]], axis=-1)


def rmsnorm(x, gain):
    x32 = x.astype(jnp.float32)
    y = x32 * lax.rsqrt(jnp.mean(x32 * x32, axis=-1, keepdims=True) + NORM_EPS) * gain.astype(jnp.float32)
    return y.astype(x.dtype)


def _linear_scan(a, b, axis):
    def combine(e1, e2):
        a1, b1 = e1
        a2, b2 = e2
        return a1 * a2, a2 * b1 + b2
    _, h = lax.associative_scan(combine, (a, b), axis=axis)
    return h


def gla_mix(q, k, v, g, dlr, w_decay2, b_decay, norm_gain):
    f32 = jnp.float32
    bsz, seq, _ = q.shape
    n_c = seq // GLA_CHUNK
    q = q.astype(f32).reshape(bsz, n_c, GLA_CHUNK, GLA_HEADS, GLA_DK) * GLA_DK ** -0.5
    k = k.astype(f32).reshape(bsz, n_c, GLA_CHUNK, GLA_HEADS, GLA_DK)
    v = v.astype(f32).reshape(bsz, n_c, GLA_CHUNK, GLA_HEADS, GLA_DV)
    log_a = jax.nn.log_sigmoid(dlr.astype(f32) @ w_decay2.astype(f32) + b_decay.astype(f32)) / GLA_TAU
    log_a = log_a.reshape(bsz, n_c, GLA_CHUNK, GLA_HEADS, GLA_DK)
    b = jnp.cumsum(log_a, axis=2)
    b_last = b[:, :, -1:]
    q_in = q * jnp.exp(b)
    k_in = k * jnp.exp(-b)
    scores = jnp.einsum('bnthd,bnshd->bnhts', q_in, k_in)
    causal = jnp.tril(jnp.ones((GLA_CHUNK, GLA_CHUNK), dtype=bool))
    scores = jnp.where(causal, scores, 0.0)
    o_intra = jnp.einsum('bnhts,bnshv->bnthv', scores, v)
    k_state = k * jnp.exp(b_last - b)
    d_state = jnp.einsum('bnshd,bnshv->nbhdv', k_state, v)
    chunk_decay = jnp.transpose(jnp.exp(b_last[:, :, 0]), (1, 0, 2, 3))

    def step(state, inp):
        dec, ds = inp
        return dec[..., None] * state + ds, state

    s0 = jnp.zeros((bsz, GLA_HEADS, GLA_DK, GLA_DV), f32)
    _, s_prev = lax.scan(step, s0, (chunk_decay, d_state))
    o_inter = jnp.einsum('bnthd,nbhdv->bnthv', q_in, s_prev)
    o = (o_intra + o_inter).reshape(bsz, seq, GLA_HEADS, GLA_DV)
    o = rmsnorm(o, norm_gain).reshape(bsz, seq, MIX_W)
    return o * jax.nn.silu(g.astype(f32))


def s5_mix(u, lam_re, lam_im, log_step, b_re, b_im, c_re, c_im, d_skip, w_glu, b_glu):
    f32 = jnp.float32
    bsz, seq, _ = u.shape
    u32 = u.astype(f32)
    ug = u32.reshape(bsz, seq, S5_GROUPS, S5_GROUP)
    lam = lax.complex(jnp.minimum(lam_re.astype(f32), -1e-4), lam_im.astype(f32))
    delta = jnp.exp(log_step.astype(f32))[:, None]
    lam_bar = jnp.exp(lam * delta)
    b_mat = lax.complex(b_re.astype(f32), b_im.astype(f32))
    b_bar = ((lam_bar - 1.0) / lam)[..., None] * b_mat
    bu = jnp.einsum('blgc,gnc->blgn', ug.astype(jnp.complex64), b_bar)
    h = _linear_scan(jnp.broadcast_to(lam_bar, bu.shape), bu, axis=1)
    c_mat = lax.complex(c_re.astype(f32), c_im.astype(f32))
    y = jnp.real(jnp.einsum('blgn,gcn->blgc', h, c_mat)).reshape(bsz, seq, MIX_W)
    y = y + d_skip.astype(f32) * u32
    return jax.nn.gelu(y) * jax.nn.sigmoid(y @ w_glu.astype(f32) + b_glu.astype(f32))


def rwkv7_mix(p, mu, w0, w2, a0, a2, g2, k_k, k_a, r_k, ln_gain, ln_bias):
    f32 = jnp.float32
    bsz, seq, _ = p.shape
    p = p.astype(f32)
    prev = jnp.pad(p, ((0, 0), (1, 0), (0, 0)))[:, :-1]
    p = p + (prev - p) * mu.astype(f32)
    r, w1, k, v, a1, g1 = _split(p, RWKV_SIZES)
    w = -jax.nn.softplus(-(w0.astype(f32) + jnp.tanh(w1) @ w2.astype(f32))) - 0.5
    decay = jnp.exp(-jnp.exp(w))
    a = jax.nn.sigmoid(a0.astype(f32) + a1 @ a2.astype(f32))
    g = jax.nn.sigmoid(g1) @ g2.astype(f32)
    heads = lambda t: t.reshape(bsz, seq, RWKV_HEADS, RWKV_HEAD)
    kk = heads(k * k_k.astype(f32))
    kk = kk / jnp.maximum(jnp.sqrt(jnp.sum(kk * kk, axis=-1, keepdims=True)), 1e-12)
    k = k * (1.0 + (a - 1.0) * k_a.astype(f32))
    r_h, k_h, v_h, a_h, w_h = heads(r), heads(k), heads(v), heads(a), heads(decay)

    def step(state, inp):
        r_t, w_t, k_t, v_t, kk_t, a_t = inp
        sa = jnp.einsum('bhij,bhj->bhi', state, kk_t)
        state = (state * w_t[:, :, None, :]
                 - sa[..., None] * (kk_t * a_t)[:, :, None, :]
                 + v_t[..., None] * k_t[:, :, None, :])
        return state, jnp.einsum('bhij,bhj->bhi', state, r_t)

    tm = lambda t: jnp.moveaxis(t, 1, 0)
    s0 = jnp.zeros((bsz, RWKV_HEADS, RWKV_HEAD, RWKV_HEAD), f32)
    _, y = lax.scan(step, s0, (tm(r_h), tm(w_h), tm(k_h), tm(v_h), tm(kk), tm(a_h)))
    y = jnp.moveaxis(y, 0, 1)
    mean = jnp.mean(y, axis=-1, keepdims=True)
    var = jnp.mean(jnp.square(y - mean), axis=-1, keepdims=True)
    y = ((y - mean) * lax.rsqrt(var + RWKV_GN_EPS)).reshape(bsz, seq, MIX_W)
    y = y * ln_gain.astype(f32) + ln_bias.astype(f32)
    bonus = jnp.sum(r_h * k_h * r_k.astype(f32), axis=-1, keepdims=True) * v_h
    y = y + bonus.reshape(bsz, seq, MIX_W)
    return y * g


def rglru_mix(xb, gate, conv_w, conv_b, w_a, b_a, w_x, b_x, lam):
    f32 = jnp.float32
    bsz, seq, _ = xb.shape
    xc = lax.conv_general_dilated(
        xb.astype(f32), conv_w.astype(f32)[:, None, :], window_strides=(1,),
        padding=((LRU_CONV - 1, 0),), dimension_numbers=('NWC', 'WIO', 'NWC'),
        feature_group_count=MIX_W) + conv_b.astype(f32)
    xg = xc.reshape(bsz, seq, LRU_BLOCKS, LRU_BLOCK)
    r = jax.nn.sigmoid(jnp.einsum('blhi,hij->blhj', xg, w_a.astype(f32)).reshape(bsz, seq, MIX_W) + b_a.astype(f32))
    i = jax.nn.sigmoid(jnp.einsum('blhi,hij->blhj', xg, w_x.astype(f32)).reshape(bsz, seq, MIX_W) + b_x.astype(f32))
    log_a = -LRU_C * r * jax.nn.softplus(-lam.astype(f32))
    a = jnp.exp(log_a)
    mult = jnp.sqrt(-jnp.expm1(2.0 * log_a))
    h = _linear_scan(a, mult * (i * xc), axis=1)
    return h * jax.nn.gelu(gate.astype(f32))


def cross_attention(xn, memn, wq, wk, wv, wo):
    f32 = jnp.float32
    bsz, seq, _ = xn.shape
    q = (xn @ wq).astype(f32).reshape(bsz, seq, XA_HEADS, XA_HEAD_DIM)
    k = (memn @ wk).astype(f32).reshape(bsz, MEM_LEN, XA_HEADS, XA_HEAD_DIM)
    v = (memn @ wv).astype(f32).reshape(bsz, MEM_LEN, XA_HEADS, XA_HEAD_DIM)
    s = jnp.einsum('blhd,bmhd->bhlm', q, k) * XA_HEAD_DIM ** -0.5
    prob = jax.nn.softmax(s, axis=-1)
    o = jnp.einsum('bhlm,bmhd->blhd', prob, v).reshape(bsz, seq, D_MODEL)
    return (o @ wo.astype(f32)).astype(xn.dtype)


def squared_relu_mlp(xn, w1, w2):
    return jnp.square(jax.nn.relu(xn @ w1)) @ w2


def setup_inputs(seed: int = 0) -> dict:
    key = jax.random.key(seed)
    keys = jax.random.split(key, 64)
    counter = [0]

    def nk():
        kk = keys[counter[0]]
        counter[0] += 1
        return kk

    def nrm(shape, scale=1.0):
        return scale * jax.random.normal(nk(), shape, jnp.float32)

    def unif(shape, lo, hi):
        return jax.random.uniform(nk(), shape, jnp.float32, lo, hi)

    n_idx = jnp.arange(S5_STATE, dtype=jnp.float32)
    w0_base = jnp.tile(jnp.linspace(-6.0, -1.0, RWKV_HEAD, dtype=jnp.float32), RWKV_HEADS)
    x = nrm((BATCH, SEQ, D_MODEL))
    mem = nrm((BATCH, MEM_LEN, D_MODEL))
    norm_gain = 1.0 + nrm((DEPTH, N_NORMS, D_MODEL), 0.05)
    xa_wq = nrm((DEPTH, D_MODEL, D_MODEL), D_MODEL ** -0.5)
    xa_wk = nrm((DEPTH, D_MODEL, D_MODEL), D_MODEL ** -0.5)
    xa_wv = nrm((DEPTH, D_MODEL, D_MODEL), D_MODEL ** -0.5)
    xa_wo = nrm((DEPTH, D_MODEL, D_MODEL), D_MODEL ** -0.5)
    mlp_w1 = nrm((DEPTH, D_MODEL, D_FF), D_MODEL ** -0.5)
    mlp_w2 = nrm((DEPTH, D_FF, D_MODEL), D_FF ** -0.5)
    ab_w_in = nrm((N_AB, D_MODEL, AB_COLS), D_MODEL ** -0.5)
    gla_w_decay2 = nrm((N_AB, GLA_RANK, GLA_HEADS * GLA_DK), GLA_RANK ** -0.5)
    gla_b_decay = nrm((N_AB, GLA_HEADS * GLA_DK), 0.1)
    gla_norm_gain = 1.0 + nrm((N_AB, GLA_HEADS, GLA_DV), 0.05)
    s5_lambda_re = -0.5 + nrm((N_AB, S5_GROUPS, S5_STATE), 0.01)
    s5_lambda_im = math.pi * n_idx + nrm((N_AB, S5_GROUPS, S5_STATE), 0.01)
    s5_log_step = unif((N_AB, S5_GROUPS), math.log(1e-3), math.log(1e-1))
    s5_b_re = nrm((N_AB, S5_GROUPS, S5_STATE, S5_GROUP), (2.0 * S5_GROUP) ** -0.5)
    s5_b_im = nrm((N_AB, S5_GROUPS, S5_STATE, S5_GROUP), (2.0 * S5_GROUP) ** -0.5)
    s5_c_re = nrm((N_AB, S5_GROUPS, S5_GROUP, S5_STATE), (2.0 * S5_STATE) ** -0.5)
    s5_c_im = nrm((N_AB, S5_GROUPS, S5_GROUP, S5_STATE), (2.0 * S5_STATE) ** -0.5)
    s5_d = nrm((N_AB, MIX_W))
    s5_w_glu = nrm((N_AB, MIX_W, MIX_W), MIX_W ** -0.5)
    s5_b_glu = nrm((N_AB, MIX_W), 0.01)
    ab_w_out = nrm((N_AB, 2 * MIX_W, D_MODEL), (2 * MIX_W) ** -0.5)
    cd_w_in = nrm((N_CD, D_MODEL, CD_COLS), D_MODEL ** -0.5)
    rwkv_mu = unif((N_CD, RWKV_COLS), 0.0, 1.0)
    rwkv_w0 = w0_base + nrm((N_CD, MIX_W), 0.1)
    rwkv_w2 = nrm((N_CD, RWKV_DECAY_RANK, MIX_W), 0.5 * RWKV_DECAY_RANK ** -0.5)
    rwkv_a0 = nrm((N_CD, MIX_W), 0.1)
    rwkv_a2 = nrm((N_CD, RWKV_A_RANK, MIX_W), 0.5 * RWKV_A_RANK ** -0.5)
    rwkv_g2 = nrm((N_CD, RWKV_GATE_RANK, MIX_W), RWKV_GATE_RANK ** -0.5)
    rwkv_k_k = 0.85 + nrm((N_CD, MIX_W), 0.05)
    rwkv_k_a = 1.0 + nrm((N_CD, MIX_W), 0.05)
    rwkv_r_k = nrm((N_CD, RWKV_HEADS, RWKV_HEAD), 0.1)
    rwkv_ln_gain = 1.0 + nrm((N_CD, MIX_W), 0.05)
    rwkv_ln_bias = nrm((N_CD, MIX_W), 0.01)
    lru_conv_w = nrm((N_CD, LRU_CONV, MIX_W), LRU_CONV ** -0.5)
    lru_conv_b = nrm((N_CD, MIX_W), 0.01)
    lru_w_a = nrm((N_CD, LRU_BLOCKS, LRU_BLOCK, LRU_BLOCK), LRU_BLOCK ** -0.5)
    lru_b_a = nrm((N_CD, MIX_W), 0.01)
    lru_w_x = nrm((N_CD, LRU_BLOCKS, LRU_BLOCK, LRU_BLOCK), LRU_BLOCK ** -0.5)
    lru_b_x = nrm((N_CD, MIX_W), 0.01)
    lru_a = unif((N_CD, MIX_W), 0.9, 0.999) ** (1.0 / LRU_C)
    lru_lambda = jnp.log(lru_a) - jnp.log1p(-lru_a)
    cd_w_out = nrm((N_CD, 2 * MIX_W, D_MODEL), (2 * MIX_W) ** -0.5)
    return {
        'x': x, 'mem': mem, 'norm_gain': norm_gain,
        'xa_wq': xa_wq, 'xa_wk': xa_wk, 'xa_wv': xa_wv, 'xa_wo': xa_wo,
        'mlp_w1': mlp_w1, 'mlp_w2': mlp_w2,
        'ab_w_in': ab_w_in, 'gla_w_decay2': gla_w_decay2, 'gla_b_decay': gla_b_decay,
        'gla_norm_gain': gla_norm_gain,
        's5_lambda_re': s5_lambda_re, 's5_lambda_im': s5_lambda_im, 's5_log_step': s5_log_step,
        's5_b_re': s5_b_re, 's5_b_im': s5_b_im, 's5_c_re': s5_c_re, 's5_c_im': s5_c_im,
        's5_d': s5_d, 's5_w_glu': s5_w_glu, 's5_b_glu': s5_b_glu, 'ab_w_out': ab_w_out,
        'cd_w_in': cd_w_in, 'rwkv_mu': rwkv_mu, 'rwkv_w0': rwkv_w0, 'rwkv_w2': rwkv_w2,
        'rwkv_a0': rwkv_a0, 'rwkv_a2': rwkv_a2, 'rwkv_g2': rwkv_g2, 'rwkv_k_k': rwkv_k_k,
        'rwkv_k_a': rwkv_k_a, 'rwkv_r_k': rwkv_r_k, 'rwkv_ln_gain': rwkv_ln_gain,
        'rwkv_ln_bias': rwkv_ln_bias, 'lru_conv_w': lru_conv_w, 'lru_conv_b': lru_conv_b,
        'lru_w_a': lru_w_a, 'lru_b_a': lru_b_a, 'lru_w_x': lru_w_x, 'lru_b_x': lru_b_x,
        'lru_lambda': lru_lambda, 'cd_w_out': cd_w_out,
    }


def reference(x, mem, norm_gain, xa_wq, xa_wk, xa_wv, xa_wo, mlp_w1, mlp_w2,
              ab_w_in, gla_w_decay2, gla_b_decay, gla_norm_gain,
              s5_lambda_re, s5_lambda_im, s5_log_step, s5_b_re, s5_b_im, s5_c_re, s5_c_im,
              s5_d, s5_w_glu, s5_b_glu, ab_w_out,
              cd_w_in, rwkv_mu, rwkv_w0, rwkv_w2, rwkv_a0, rwkv_a2, rwkv_g2, rwkv_k_k,
              rwkv_k_a, rwkv_r_k, rwkv_ln_gain, rwkv_ln_bias,
              lru_conv_w, lru_conv_b, lru_w_a, lru_b_a, lru_w_x, lru_b_x, lru_lambda, cd_w_out):
    f32 = jnp.float32
    h = x
    for layer in range(DEPTH):
        g = norm_gain[layer]
        i = layer // 2
        hn = rmsnorm(h, g[0])
        if layer % 2 == 0:
            q, k, v, gate, dlr, u = _split(hn @ ab_w_in[i], AB_SIZES)
            o_a = gla_mix(q, k, v, gate, dlr, gla_w_decay2[i], gla_b_decay[i], gla_norm_gain[i])
            o_b = s5_mix(u, s5_lambda_re[i], s5_lambda_im[i], s5_log_step[i], s5_b_re[i], s5_b_im[i],
                         s5_c_re[i], s5_c_im[i], s5_d[i], s5_w_glu[i], s5_b_glu[i])
            mix = jnp.concatenate([o_a, o_b], axis=-1) @ ab_w_out[i].astype(f32)
        else:
            p_rwkv, xb, gate = _split(hn @ cd_w_in[i], CD_SIZES)
            o_c = rwkv7_mix(p_rwkv, rwkv_mu[i], rwkv_w0[i], rwkv_w2[i], rwkv_a0[i], rwkv_a2[i],
                            rwkv_g2[i], rwkv_k_k[i], rwkv_k_a[i], rwkv_r_k[i],
                            rwkv_ln_gain[i], rwkv_ln_bias[i])
            o_d = rglru_mix(xb, gate, lru_conv_w[i], lru_conv_b[i], lru_w_a[i], lru_b_a[i],
                            lru_w_x[i], lru_b_x[i], lru_lambda[i])
            mix = jnp.concatenate([o_c, o_d], axis=-1) @ cd_w_out[i].astype(f32)
        h = h + rmsnorm(mix, g[1]).astype(h.dtype)
        memn = rmsnorm(mem, g[6])
        xa = cross_attention(rmsnorm(h, g[2]), memn, xa_wq[layer], xa_wk[layer], xa_wv[layer], xa_wo[layer])
        h = h + rmsnorm(xa, g[3]).astype(h.dtype)
        ff = squared_relu_mlp(rmsnorm(h, g[4]), mlp_w1[layer], mlp_w2[layer])
        h = h + rmsnorm(ff, g[5]).astype(h.dtype)
    return h
```

```cpp
#include <hip/hip_runtime.h>
#include <hip/hip_cooperative_groups.h>
#include <cstdio>
#include <cstdint>
#include <cstring>
namespace cg = cooperative_groups;

typedef unsigned short u16;
typedef __attribute__((ext_vector_type(8))) short bf16x8;
typedef __attribute__((ext_vector_type(4))) float f32x4;

#define T_TOK 16384
#define SEQL 4096
#define NTHR 256

typedef float float2v_ __attribute__((ext_vector_type(2)));
typedef __bf16 bf16x2v_ __attribute__((ext_vector_type(2)));
__device__ __forceinline__ unsigned pack2(float lo, float hi) {
  float2v_ f = {lo, hi};
  bf16x2v_ b = __builtin_convertvector(f, bf16x2v_);
  return __builtin_bit_cast(unsigned, b);
}
__device__ __forceinline__ float bflo(unsigned u) { return __uint_as_float(u << 16); }
__device__ __forceinline__ float bfhi(unsigned u) { return __uint_as_float(u & 0xffff0000u); }
__device__ __forceinline__ float bf2f(u16 h) { return __uint_as_float(((unsigned)h) << 16); }
__device__ __forceinline__ u16 f2bf(float f) { return (u16)(pack2(f, 0.f) & 0xffffu); }
__device__ __forceinline__ void unpack4(uint2 u, float* f) { f[0] = bflo(u.x); f[1] = bfhi(u.x); f[2] = bflo(u.y); f[3] = bfhi(u.y); }
__device__ __forceinline__ uint2 pack4(float a, float b, float c, float d) { return make_uint2(pack2(a, b), pack2(c, d)); }
__device__ __forceinline__ bf16x8 pack8(const float* f) {
  union { bf16x8 v; unsigned u[4]; } r;
  r.u[0] = pack2(f[0], f[1]); r.u[1] = pack2(f[2], f[3]); r.u[2] = pack2(f[4], f[5]); r.u[3] = pack2(f[6], f[7]);
  return r.v;
}
__device__ __forceinline__ void unpack8(uint4 u, float* f) {
  f[0] = bflo(u.x); f[1] = bfhi(u.x); f[2] = bflo(u.y); f[3] = bfhi(u.y);
  f[4] = bflo(u.z); f[5] = bfhi(u.z); f[6] = bflo(u.w); f[7] = bfhi(u.w);
}
__device__ __forceinline__ float frcp(float x) { return __builtin_amdgcn_rcpf(x); }
__device__ __forceinline__ float sigmoidf_(float x) { return frcp(1.f + __expf(-x)); }
__device__ __forceinline__ float softplusf_(float z) { return fmaxf(z, 0.f) + __logf(1.f + __expf(-fabsf(z))); }
__device__ __forceinline__ float logsigmoidf_(float x) { return fminf(x, 0.f) - __logf(1.f + __expf(-fabsf(x))); }
__device__ __forceinline__ float fast_tanh(float x) { return 1.f - 2.f * frcp(1.f + __expf(2.f * x)); }
__device__ __forceinline__ float gelu_tanh(float x) {
  const float u2 = 1.5957691216057308f * (x + 0.044715f * x * x * x);
  return x * frcp(1.f + __expf(-u2));
}
__device__ __forceinline__ float xadd16(float x) { unsigned a = __float_as_uint(x); auto r = __builtin_amdgcn_permlane16_swap(a, a, false, false); return __uint_as_float(r[0]) + __uint_as_float(r[1]); }
__device__ __forceinline__ float xadd32(float x) { unsigned a = __float_as_uint(x); auto r = __builtin_amdgcn_permlane32_swap(a, a, false, false); return __uint_as_float(r[0]) + __uint_as_float(r[1]); }
__device__ __forceinline__ float xmax16(float x) { unsigned a = __float_as_uint(x); auto r = __builtin_amdgcn_permlane16_swap(a, a, false, false); return fmaxf(__uint_as_float(r[0]), __uint_as_float(r[1])); }
__device__ __forceinline__ float xmax32(float x) { unsigned a = __float_as_uint(x); auto r = __builtin_amdgcn_permlane32_swap(a, a, false, false); return fmaxf(__uint_as_float(r[0]), __uint_as_float(r[1])); }
template <int CTRL>
__device__ __forceinline__ float dppf(float x) {
  return __int_as_float(__builtin_amdgcn_mov_dpp(__float_as_int(x), CTRL, 0xf, 0xf, true));
}
__device__ __forceinline__ float sum16(float x) {
  x += dppf<0xB1>(x);
  x += dppf<0x4E>(x);
  x += dppf<0x141>(x);
  x += dppf<0x140>(x);
  return x;
}
__device__ __forceinline__ int ltid() { int t = threadIdx.x; asm volatile("" : "+v"(t)); return t; }
__device__ __forceinline__ float wave_sum(float v) {
  v = sum16(v);
  return xadd32(xadd16(v));
}
#define MFMA16(a, b, c) __builtin_amdgcn_mfma_f32_16x16x32_bf16((a), (b), (c), 0, 0, 0)

struct TDesc { const float* src; u16* dst; int K, N, Npad, t0; };
#define MAXT 40
struct P {
  const float *x, *mem, *norm_gain, *wq, *wk, *wv, *wo, *w1, *w2;
  const float *ab_w_in, *gla_w2, *gla_bd, *gla_ng, *s5_lre, *s5_lim, *s5_ls, *s5_bre, *s5_bim, *s5_cre, *s5_cim, *s5_d,
      *s5_wglu, *s5_bglu, *ab_w_out;
  const float *cd_w_in, *mu, *w0, *rw2, *a0, *ra2, *rg2, *k_k, *k_a, *r_k, *ln_g, *ln_b, *conv_w, *conv_b, *lw_a, *lb_a,
      *lw_x, *lb_x, *llam, *cd_w_out;
  float* out;
  u16 *Wq, *Wk, *Wv, *Wo, *W1, *W2;
  u16 *Win0, *Wout0, *Wglu, *S5W1, *S5W2, *Win1, *Wout1, *Rw2t, *Ra2t, *Rg2t, *Lwt;
  u16 *memn, *Kp, *Vt;
  u16 *A, *B;
  char* H;
  float* gdec;
  float* c3buf;
  unsigned* bar;
  TDesc tab0[MAXT];
  TDesc tab1[8];
  int ntab0, ntiles0, ntab1, ntiles1;
  int nseq, pad_;
  unsigned char seq[64];
};

#define GST 32
#define GSW(row, q) ((((q) ^ ((0 - (((row) & 15) >> 2)) & 3))) * 8)
template <class AL, class EP>
__device__ __forceinline__ void gemm_tile(const AL& al, const u16* __restrict__ Wt, int K, int m0, int n0, int nt,
                                          const EP& ep, u16* sm) {
  const int tid = ltid(), lane = tid & 63, wave = tid >> 6;
  const int wm = wave >> 1, wn = wave & 1;
  u16* As = sm;
  u16* Bs = sm + 2 * 128 * GST;
  const int lr0 = tid >> 2, lkc = (tid & 3) * 8;
  const int lsw = GSW(lr0, tid & 3);
  const int rsw = GSW(lane & 15, lane >> 4);
  f32x4 acc[4][4];
#pragma unroll
  for (int i = 0; i < 4; i++)
#pragma unroll
    for (int j = 0; j < 4; j++) acc[i][j] = (f32x4){0.f, 0.f, 0.f, 0.f};
  const u16* wp0 = Wt + (size_t)(n0 + lr0) * K + lkc;
  const u16* wp1 = Wt + (size_t)(n0 + lr0 + 64) * K + lkc;
  const int nk = K >> 5;
  bf16x8 e0, e1, e2, e3;
  bf16x8 o0, o1, o2, o3;
#define G_LOAD(r0, r1, r2, r3, kt_)                                                    \
  { const int k0_ = (kt_) * 32; r0 = al(m0 + lr0, k0_ + lkc, nt); r1 = al(m0 + lr0 + 64, k0_ + lkc, nt); \
    r2 = *(const bf16x8*)(wp0 + k0_); r3 = *(const bf16x8*)(wp1 + k0_); }
#define G_STORE(r0, r1, r2, r3, buf_)                                                  \
  { u16* An_ = As + (buf_) * 128 * GST; u16* Bn_ = Bs + (buf_) * 128 * GST;             \
    *(bf16x8*)(An_ + lr0 * GST + lsw) = r0; *(bf16x8*)(An_ + (lr0 + 64) * GST + lsw) = r1; \
    *(bf16x8*)(Bn_ + lr0 * GST + lsw) = r2; *(bf16x8*)(Bn_ + (lr0 + 64) * GST + lsw) = r3; }
#define G_COMPUTE(buf_)                                                                \
  { const u16* Ac_ = As + (buf_) * 128 * GST; const u16* Bc_ = Bs + (buf_) * 128 * GST; \
    bf16x8 wf[4], xf[4];                                                               \
    _Pragma("unroll") for (int i = 0; i < 4; i++) wf[i] = *(const bf16x8*)(Bc_ + (wn * 64 + i * 16 + (lane & 15)) * GST + rsw); \
    _Pragma("unroll") for (int i = 0; i < 4; i++) xf[i] = *(const bf16x8*)(Ac_ + (wm * 64 + i * 16 + (lane & 15)) * GST + rsw); \
    _Pragma("unroll") for (int i = 0; i < 4; i++)                                      \
      _Pragma("unroll") for (int j = 0; j < 4; j++) acc[i][j] = MFMA16(wf[i], xf[j], acc[i][j]); }
  G_LOAD(e0, e1, e2, e3, 0);
  G_LOAD(o0, o1, o2, o3, 1);
  G_STORE(e0, e1, e2, e3, 0);
  if (nk > 2) G_LOAD(e0, e1, e2, e3, 2);
  __syncthreads();
  for (int kt = 0; kt < nk; kt += 2) {
    G_COMPUTE(0);
    G_STORE(o0, o1, o2, o3, 1);
    if (kt + 3 < nk) G_LOAD(o0, o1, o2, o3, kt + 3);
    __syncthreads();
    G_COMPUTE(1);
    if (kt + 2 < nk) {
      G_STORE(e0, e1, e2, e3, 0);
      if (kt + 4 < nk) G_LOAD(e0, e1, e2, e3, kt + 4);
    }
    __syncthreads();
  }
#undef G_LOAD
#undef G_STORE
#undef G_COMPUTE
  ep(acc, m0 + wm * 64, n0 + wn * 64, lane, nt);
}

struct ALbf {
  const u16* A; int lda;
  __device__ __forceinline__ bf16x8 operator()(int m, int k, int) const { return *(const bf16x8*)(A + (size_t)m * lda + k); }
};
#define GB_STAGE_EL (384 * GST)
#define WAIT_V(n) asm volatile("s_waitcnt vmcnt(%0)" ::"n"(n) : "memory")
#define RAW_BARRIER() do { asm volatile("s_waitcnt lgkmcnt(0)" ::: "memory"); __builtin_amdgcn_s_barrier(); } while (0)
typedef __attribute__((address_space(3))) unsigned lds_u32;
__device__ __forceinline__ void gb_issue(const u16* ga, const u16* gw, size_t a64, size_t w64, int ko, u16* __restrict__ wr, int wave) {
#pragma unroll
  for (int i = 0; i < 4; i++)
    __builtin_amdgcn_global_load_lds((const unsigned*)(ga + i * a64 + ko), (lds_u32*)(wr + (i * 4 + wave) * 512), 16, 0, 0);
#pragma unroll
  for (int i = 0; i < 2; i++)
    __builtin_amdgcn_global_load_lds((const unsigned*)(gw + i * w64 + ko), (lds_u32*)(wr + 256 * GST + (i * 4 + wave) * 512), 16, 0, 0);
}
__device__ __forceinline__ void gb_step(const u16* ga, const u16* gw, size_t a64, size_t w64, int ko, bool issue,
                                        const u16* __restrict__ rd, u16* __restrict__ wr, int wave, int wm, int wn, int lane, int rsw,
                                        f32x4 (&acc)[4][8]) {
  if (issue) {
#pragma unroll
    for (int i = 0; i < 4; i++)
      __builtin_amdgcn_global_load_lds((const unsigned*)(ga + i * a64 + ko), (lds_u32*)(wr + (i * 4 + wave) * 512), 16, 0, 0);
#pragma unroll
    for (int i = 0; i < 2; i++)
      __builtin_amdgcn_global_load_lds((const unsigned*)(gw + i * w64 + ko), (lds_u32*)(wr + 256 * GST + (i * 4 + wave) * 512), 16, 0, 0);
  }
  const unsigned rdb = (unsigned)(size_t)(__attribute__((address_space(3))) const char*)rd;
  const unsigned ab = rdb + (unsigned)(((wm * 128 + (lane & 15)) * GST + rsw) * 2);
  const int wr0 = wn * 64 + (((lane & 15) >> 2) << 3) + (lane & 3);
  const unsigned bb0 = rdb + (unsigned)((256 * GST + wr0 * GST + GSW(wr0, lane >> 4)) * 2);
  const unsigned bb1 = rdb + (unsigned)((256 * GST + (wr0 + 4) * GST + GSW(wr0 + 4, lane >> 4)) * 2);
  bf16x8 wf0, wf1, wf2, wf3, xf0, xf1, xf2, xf3, xf4, xf5, xf6, xf7;
#define DSR(dst, addr, off) asm volatile("ds_read_b128 %0, %1 offset:%2" : "=v"(dst) : "v"(addr), "n"(off) : "memory")
  DSR(wf0, bb0, 0); DSR(wf1, bb1, 0); DSR(wf2, bb0, 2048); DSR(wf3, bb1, 2048);
  DSR(xf0, ab, 0); DSR(xf1, ab, 1024); DSR(xf2, ab, 2048); DSR(xf3, ab, 3072);
  DSR(xf4, ab, 4096); DSR(xf5, ab, 5120); DSR(xf6, ab, 6144); DSR(xf7, ab, 7168);
#undef DSR
#define MM(j, xf)                                                                     \
  acc[0][j] = MFMA16(wf0, xf, acc[0][j]); acc[1][j] = MFMA16(wf1, xf, acc[1][j]);      \
  acc[2][j] = MFMA16(wf2, xf, acc[2][j]); acc[3][j] = MFMA16(wf3, xf, acc[3][j]);
  asm volatile("s_waitcnt lgkmcnt(7)" : "+v"(wf0), "+v"(wf1), "+v"(wf2), "+v"(wf3), "+v"(xf0) : : "memory");
  MM(0, xf0)
  asm volatile("s_waitcnt lgkmcnt(6)" : "+v"(xf1) : : "memory");
  MM(1, xf1)
  asm volatile("s_waitcnt lgkmcnt(5)" : "+v"(xf2) : : "memory");
  MM(2, xf2)
  asm volatile("s_waitcnt lgkmcnt(4)" : "+v"(xf3) : : "memory");
  MM(3, xf3)
  asm volatile("s_waitcnt lgkmcnt(3)" : "+v"(xf4) : : "memory");
  MM(4, xf4)
  asm volatile("s_waitcnt lgkmcnt(2)" : "+v"(xf5) : : "memory");
  MM(5, xf5)
  asm volatile("s_waitcnt lgkmcnt(1)" : "+v"(xf6) : : "memory");
  MM(6, xf6)
  asm volatile("s_waitcnt lgkmcnt(0)" : "+v"(xf7) : : "memory");
  MM(7, xf7)
#undef MM
}
template <class F>
__device__ __forceinline__ void gemm_big(const ALbf& al, const u16* __restrict__ Wt, int K, int m0, int n0, const F& f, u16* sm) {
  const int tid = ltid(), lane = tid & 63, wave = tid >> 6;
  const int wm = wave >> 1, wn = wave & 1;
  const int rsw = GSW(lane & 15, lane >> 4);
  f32x4 acc[4][8];
#pragma unroll
  for (int i = 0; i < 4; i++)
#pragma unroll
    for (int j = 0; j < 8; j++) acc[i][j] = (f32x4){0.f, 0.f, 0.f, 0.f};
  const int srow = lane >> 2;
  const int scol = ((lane & 3) ^ ((0 - (srow >> 2)) & 3)) * 8;
  const u16* ga = al.A + (size_t)(m0 + wave * 16 + srow) * al.lda + scol;
  const u16* gw = Wt + (size_t)(n0 + wave * 16 + srow) * K + scol;
  const size_t a64 = (size_t)64 * al.lda, w64 = (size_t)64 * K;
  const int nk = K >> 5;
  WAIT_V(0);
  gb_issue(ga, gw, a64, w64, 0, sm, wave);
  gb_issue(ga, gw, a64, w64, 32, sm + GB_STAGE_EL, wave);
  WAIT_V(6);
  RAW_BARRIER();
  int cur = 0;
  for (int kt = 0; kt < nk; ++kt) {
    const int nxt2 = (cur >= 1) ? cur - 1 : 2;
    gb_step(ga, gw, a64, w64, (kt + 2) * 32, kt + 2 < nk, sm + cur * GB_STAGE_EL, sm + nxt2 * GB_STAGE_EL, wave, wm, wn, lane, rsw, acc);
    if (kt + 2 < nk) WAIT_V(6); else WAIT_V(0);
    RAW_BARRIER();
    cur = (cur == 2) ? 0 : cur + 1;
  }
#pragma unroll
  for (int pq = 0; pq < 2; pq++)
#pragma unroll
    for (int j = 0; j < 8; j++)
      f(m0 + wm * 128 + j * 16 + (lane & 15), n0 + wn * 64 + pq * 32 + (lane >> 4) * 8, acc[2 * pq][j], acc[2 * pq + 1][j]);
}
__device__ __forceinline__ uint4 pack8v(const f32x4& a, const f32x4& b) {
  return make_uint4(pack2(a[0], a[1]), pack2(a[2], a[3]), pack2(b[0], b[1]), pack2(b[2], b[3]));
}
template <class F>
__device__ __forceinline__ void gemm_big_jobs(const ALbf& al, const u16* Wt, int K, int Nt, const F& f, u16* sm, int job0, int jstride) {
  for (int t = job0; t < 64 * Nt; t += jstride) gemm_big(al, Wt, K, (t & 63) * 256, (t >> 6) * 128, f, sm);
}

struct ALf32 {
  const float* A; int lda;
  __device__ __forceinline__ bf16x8 operator()(int m, int k, int) const {
    const float4* p = (const float4*)(A + (size_t)m * lda + k);
    float4 a = p[0], b = p[1];
    float f[8] = {a.x, a.y, a.z, a.w, b.x, b.y, b.z, b.w};
    return pack8(f);
  }
};
template <class F>
struct EPgen {
  F f;
  __device__ __forceinline__ void operator()(f32x4 (&acc)[4][4], int mw, int nw, int lane, int nt) const {
#pragma unroll
    for (int i = 0; i < 4; i++)
#pragma unroll
      for (int j = 0; j < 4; j++) f(mw + j * 16 + (lane & 15), nw + i * 16 + (lane >> 4) * 4, acc[i][j], nt);
  }
};

template <class AL, class EP>
__device__ __forceinline__ void gemm_jobs(const AL& al, const u16* Wt, int K, int Mt, int Nt, const EP& ep, u16* sm,
                                          int job0, int jstride) {
  for (int t = job0; t < Mt * Nt; t += jstride) {
    int mt = t % Mt, nt = t / Mt;
    gemm_tile(al, Wt, K, mt * 128, nt * 128, nt, ep, sm);
  }
}

__device__ __forceinline__ void transpose_tile(const TDesc& d, int tile, float* sm) {
  const int ktn = d.K >> 6;
  const int kt = tile % ktn, ntl = tile / ktn;
  const int k0 = kt * 64, n0 = ntl * 64;
  const int tid = ltid();
  __syncthreads();
#pragma unroll
  for (int i = 0; i < 16; i++) {
    int e = tid + i * 256;
    int kk = e >> 6, nn = e & 63;
    const int nc = n0 + nn;
    float v = d.src[(size_t)(k0 + kk) * d.N + (nc < d.N ? nc : d.N - 1)];
    sm[kk * 65 + nn] = (nc < d.N) ? v : 0.f;
  }
  __syncthreads();
#pragma unroll
  for (int i = 0; i < 2; i++) {
    int e = tid + i * 256;
    int nn = e >> 3, kc = (e & 7) * 8;
    float f[8];
#pragma unroll
    for (int q = 0; q < 8; q++) f[q] = sm[(kc + q) * 65 + nn];
    *(bf16x8*)(d.dst + (size_t)(n0 + nn) * d.K + k0 + kc) = pack8(f);
  }
}
__device__ __forceinline__ void transpose_jobs(const TDesc* tab, int ntab, int ntiles, float* sm, int job0, int jstride) {
  for (int t = job0; t < ntiles; t += jstride) {
    int di = 0;
    for (int i = 1; i < ntab; i++)
      if (t >= tab[i].t0) di = i;
    transpose_tile(tab[di], t - tab[di].t0, sm);
  }
}

__device__ __forceinline__ void lru_weight_job(const P& p, int h) {
  for (int e = ltid(); e < 128 * 64; e += 256) {
    const int r = e >> 6, k = e & 63;
    const int ch = (r >> 6) * 32 + ((r >> 5) & 1) * 16 + (r & 15);
    const float* src = ((r >> 4) & 1) ? p.lw_x : p.lw_a;
    p.Lwt[(size_t)(h * 128 + r) * 64 + k] = f2bf(src[h * 4096 + k * 64 + ch]);
  }
}

__device__ __forceinline__ void norm_rows(const float* in, const float* gain, u16* outb, int nrows, int job0w, int jstridew) {
  const int lane = ltid() & 63;
  for (int r = job0w; r < nrows; r += jstridew) {
    const float4* ip = (const float4*)(in + (size_t)r * 1024);
    float4 v[4];
    float ss = 0.f;
#pragma unroll
    for (int i = 0; i < 4; i++) {
      v[i] = ip[lane + i * 64];
      ss += v[i].x * v[i].x + v[i].y * v[i].y + v[i].z * v[i].z + v[i].w * v[i].w;
    }
    ss = wave_sum(ss);
    float sc = rsqrtf(ss * (1.f / 1024.f) + 1e-6f);
#pragma unroll
    for (int i = 0; i < 4; i++) {
      float4 g = ((const float4*)gain)[lane + i * 64];
      *(uint2*)(outb + (size_t)r * 1024 + (lane + i * 64) * 4) =
          pack4(v[i].x * sc * g.x, v[i].y * sc * g.y, v[i].z * sc * g.z, v[i].w * sc * g.w);
    }
  }
}
#define RN_R 2
__device__ __forceinline__ void resid_norm(const float* hin, const u16* y, const float* gpost, const float* gpre, float* hout, u16* hn,
                           int job0w, int jstridew) {
  const int lane = ltid() & 63;
  for (int r0 = job0w * RN_R; r0 < T_TOK; r0 += jstridew * RN_R) {
    uint2 yu[RN_R][4];
    float4 h4[RN_R][4];
#pragma unroll
    for (int q = 0; q < RN_R; q++)
#pragma unroll
      for (int i = 0; i < 4; i++) {
        { typedef unsigned u32x2_ __attribute__((ext_vector_type(2)));
          const u32x2_ t_ = __builtin_nontemporal_load((const u32x2_*)(y + (size_t)(r0 + q) * 1024 + (lane + i * 64) * 4));
          yu[q][i] = make_uint2(t_[0], t_[1]); }
        {
          const f32x4 t_ = __builtin_nontemporal_load((const f32x4*)(hin + (size_t)(r0 + q) * 1024) + lane + i * 64);
          h4[q][i] = make_float4(t_[0], t_[1], t_[2], t_[3]); }
      }
    float4 gp[4];
#pragma unroll
    for (int i = 0; i < 4; i++) gp[i] = ((const float4*)gpost)[lane + i * 64];
#pragma unroll
    for (int q = 0; q < RN_R; q++) {
      const int r = r0 + q;
      float yv[16];
      float ss = 0.f;
#pragma unroll
      for (int i = 0; i < 4; i++) {
        unpack4(yu[q][i], yv + i * 4);
#pragma unroll
        for (int e = 0; e < 4; e++) ss += yv[i * 4 + e] * yv[i * 4 + e];
      }
      ss = wave_sum(ss);
      const float sc = rsqrtf(ss * (1.f / 1024.f) + 1e-6f);
      float hv[16];
      float s2 = 0.f;
#pragma unroll
      for (int i = 0; i < 4; i++) {
        hv[i * 4 + 0] = h4[q][i].x + yv[i * 4 + 0] * sc * gp[i].x;
        hv[i * 4 + 1] = h4[q][i].y + yv[i * 4 + 1] * sc * gp[i].y;
        hv[i * 4 + 2] = h4[q][i].z + yv[i * 4 + 2] * sc * gp[i].z;
        hv[i * 4 + 3] = h4[q][i].w + yv[i * 4 + 3] * sc * gp[i].w;
#pragma unroll
        for (int e = 0; e < 4; e++) s2 += hv[i * 4 + e] * hv[i * 4 + e];
        __builtin_nontemporal_store((f32x4){hv[i * 4], hv[i * 4 + 1], hv[i * 4 + 2], hv[i * 4 + 3]}, (f32x4*)(hout + (size_t)r * 1024) + lane + i * 64);
      }
      if (gpre) {
        s2 = wave_sum(s2);
        const float sc2 = rsqrtf(s2 * (1.f / 1024.f) + 1e-6f);
#pragma unroll
        for (int i = 0; i < 4; i++) {
          float4 g = ((const float4*)gpre)[lane + i * 64];
          *(uint2*)(hn + (size_t)r * 1024 + (lane + i * 64) * 4) =
              pack4(hv[i * 4] * sc2 * g.x, hv[i * 4 + 1] * sc2 * g.y, hv[i * 4 + 2] * sc2 * g.z, hv[i * 4 + 3] * sc2 * g.w);
        }
      }
    }
  }
}

__device__ __forceinline__ void s5_precompute(const P& p, int g, float* sm) {
  float* lp_re = sm;
  float* lp_im = lp_re + 17 * 64;
  float* bb_re = lp_im + 17 * 64;
  float* bb_im = bb_re + 1024;
  float* c_re = bb_im + 1024;
  float* c_im = c_re + 1024;
  float* Kt = c_im + 1024;
  const int tid = ltid();
  __syncthreads();
  const float delta = expf(p.s5_ls[g]);
  for (int e = tid; e < 17 * 64; e += 256) {
    int tau = e >> 6, n = e & 63;
    float lr = fminf(p.s5_lre[g * 64 + n], -1e-4f), li = p.s5_lim[g * 64 + n];
    float a = tau * delta * lr, b = tau * delta * li;
    float s, c;
    sincosf(b, &s, &c);
    float ea = expf(a);
    lp_re[e] = ea * c; lp_im[e] = ea * s;
  }
  for (int e = tid; e < 1024; e += 256) {
    int n = e >> 4;
    float lr = fminf(p.s5_lre[g * 64 + n], -1e-4f), li = p.s5_lim[g * 64 + n];
    float a = delta * lr, b = delta * li;
    float s, c, sh, ch;
    sincosf(b, &s, &c);
    sincosf(0.5f * b, &sh, &ch);
    float zr = expm1f(a) * c - 2.f * sh * sh, zi = expf(a) * s;
    float den = 1.f / (lr * lr + li * li);
    float fr = (zr * lr + zi * li) * den, fi = (zi * lr - zr * li) * den;
    float br = p.s5_bre[(size_t)g * 1024 + e], bi = p.s5_bim[(size_t)g * 1024 + e];
    bb_re[e] = fr * br - fi * bi; bb_im[e] = fr * bi + fi * br;
    c_re[e] = p.s5_cre[(size_t)g * 1024 + e]; c_im[e] = p.s5_cim[(size_t)g * 1024 + e];
  }
  __syncthreads();
  {
    const int c = (tid >> 4) & 15, cp = tid & 15;
    float kacc[16];
#pragma unroll
    for (int t = 0; t < 16; t++) kacc[t] = 0.f;
    for (int n = 0; n < 64; n++) {
      const float cr = c_re[c * 64 + n], ci = c_im[c * 64 + n], br = bb_re[n * 16 + cp], bi = bb_im[n * 16 + cp];
      const float Pn = cr * br - ci * bi, Qn = cr * bi + ci * br;
#pragma unroll
      for (int t = 0; t < 16; t++) kacc[t] += lp_re[t * 64 + n] * Pn - lp_im[t * 64 + n] * Qn;
    }
#pragma unroll
    for (int t = 0; t < 16; t++) Kt[t * 256 + tid] = kacc[t];
  }
  __syncthreads();
  u16* W1 = p.S5W1 + (size_t)g * 384 * 256;
  for (int e = tid; e < 384 * 32; e += 256) {
    int j = e >> 5, k0 = (e & 31) * 8;
    int s = k0 >> 4, cp0 = k0 & 15;
    float f[8];
    if (j < 256) {
      int t = j >> 4, c = j & 15;
#pragma unroll
      for (int q = 0; q < 8; q++) f[q] = (s <= t) ? Kt[((t - s) * 16 + c) * 16 + cp0 + q] : 0.f;
    } else {
      int n = (j - 256) & 63;
      bool im = (j - 256) >= 64;
      float lr = lp_re[(15 - s) * 64 + n], li = lp_im[(15 - s) * 64 + n];
#pragma unroll
      for (int q = 0; q < 8; q++) {
        float br = bb_re[n * 16 + cp0 + q], bi = bb_im[n * 16 + cp0 + q];
        f[q] = im ? (lr * bi + li * br) : (lr * br - li * bi);
      }
    }
    *(bf16x8*)(W1 + (size_t)j * 256 + k0) = pack8(f);
  }
  u16* W2 = p.S5W2 + (size_t)g * 256 * 128;
  for (int e = tid; e < 256 * 16; e += 256) {
    int j = e >> 4, k0 = (e & 15) * 8;
    int t = j >> 4, c = j & 15;
    float f[8];
#pragma unroll
    for (int q = 0; q < 8; q++) {
      int k = k0 + q;
      int n = k & 63;
      float lr = lp_re[(t + 1) * 64 + n], li = lp_im[(t + 1) * 64 + n];
      float cr = c_re[c * 64 + n], ci = c_im[c * 64 + n];
      f[q] = (k < 64) ? (cr * lr - ci * li) : -(cr * li + ci * lr);
    }
    *(bf16x8*)(W2 + (size_t)j * 128 + k0) = pack8(f);
  }
}

#define PROJ0_LD 2064
__device__ __forceinline__ void gla_cumdecay(const P& p, const u16* proj, int t0, int h, float* bl, float* dl, float* w2s) {
  const int tid = ltid();
  for (int e = tid; e < 1024; e += 256) {
    int t = e >> 4, r = e & 15;
    dl[e] = bf2f(proj[(size_t)(t0 + t) * PROJ0_LD + 1536 + r]);
    int rr = e >> 6, d = e & 63;
    w2s[e] = p.gla_w2[rr * 256 + h * 64 + d];
  }
  __syncthreads();
  const int d = tid & 63, q = tid >> 6;
  const float bd = p.gla_bd[h * 64 + d];
  float run = 0.f;
  float loc[16];
#pragma unroll
  for (int i = 0; i < 16; i++) {
    int t = q * 16 + i;
    float x = bd;
#pragma unroll
    for (int r = 0; r < 16; r++) x += dl[t * 16 + r] * w2s[r * 64 + d];
    run += logsigmoidf_(x) * (1.f / 16.f);
    loc[i] = run;
  }
  bl[(q * 16 + 15) * 64 + d] = run;
  __syncthreads();
  float pre = 0.f;
  for (int qq = 0; qq < q; qq++) pre += bl[(qq * 16 + 15) * 64 + d];
  __syncthreads();
#pragma unroll
  for (int i = 0; i < 16; i++) bl[(q * 16 + i) * 64 + d] = loc[i] + pre;
  __syncthreads();
}

#define GL_ST 72
__device__ __forceinline__ void gla_state_job(const P& p, int job, char* smc) {
  const u16* proj = (const u16*)p.H;
  float* stbuf = (float*)(p.H + (size_t)T_TOK * PROJ0_LD * 2);
  const int h = job & 3, c = (job >> 2) & 63, b = job >> 8;
  const int t0 = b * SEQL + c * 64;
  float* bl = (float*)smc;
  u16* kstT = (u16*)(smc + 16384);
  u16* VtL = kstT + 64 * GL_ST;
  float* dl = (float*)(VtL + 128 * GL_ST);
  float* w2s = dl + 1024;
  const int tid = ltid(), lane = tid & 63, wave = tid >> 6;
  __syncthreads();
  gla_cumdecay(p, proj, t0, h, bl, dl, w2s);
  {
    const int s = tid >> 2, ds = (tid & 3) * 16;
    const u16* kp = proj + (size_t)(t0 + s) * PROJ0_LD + 256 + h * 64 + ds;
    float kf[16];
    unpack8(*(const uint4*)kp, kf);
    unpack8(*(const uint4*)(kp + 8), kf + 8);
#pragma unroll
    for (int i = 0; i < 16; i++) {
      int d = ds + i;
      float v = kf[i] * __expf(bl[63 * 64 + d] - bl[s * 64 + d]);
      kstT[d * GL_ST + s] = f2bf(v);
    }
    const int vs = (tid & 3) * 32;
    const u16* vp = proj + (size_t)(t0 + s) * PROJ0_LD + 512 + h * 128 + vs;
#pragma unroll
    for (int i = 0; i < 4; i++) {
      uint4 u = *(const uint4*)(vp + i * 8);
      VtL[(vs + i * 8 + 0) * GL_ST + s] = (u16)(u.x & 0xffff); VtL[(vs + i * 8 + 1) * GL_ST + s] = (u16)(u.x >> 16);
      VtL[(vs + i * 8 + 2) * GL_ST + s] = (u16)(u.y & 0xffff); VtL[(vs + i * 8 + 3) * GL_ST + s] = (u16)(u.y >> 16);
      VtL[(vs + i * 8 + 4) * GL_ST + s] = (u16)(u.z & 0xffff); VtL[(vs + i * 8 + 5) * GL_ST + s] = (u16)(u.z >> 16);
      VtL[(vs + i * 8 + 6) * GL_ST + s] = (u16)(u.w & 0xffff); VtL[(vs + i * 8 + 7) * GL_ST + s] = (u16)(u.w >> 16);
    }
    if (tid < 64) p.gdec[((b * 4 + h) * 64 + c) * 64 + tid] = __expf(bl[63 * 64 + tid]);
  }
  __syncthreads();
  f32x4 acc[8];
#pragma unroll
  for (int i = 0; i < 8; i++) acc[i] = (f32x4){0.f, 0.f, 0.f, 0.f};
#pragma unroll
  for (int kb = 0; kb < 2; kb++) {
    bf16x8 a = *(const bf16x8*)(kstT + (wave * 16 + (lane & 15)) * GL_ST + kb * 32 + (lane >> 4) * 8);
#pragma unroll
    for (int vt = 0; vt < 8; vt++) {
      bf16x8 bb = *(const bf16x8*)(VtL + (vt * 16 + (lane & 15)) * GL_ST + kb * 32 + (lane >> 4) * 8);
      acc[vt] = MFMA16(a, bb, acc[vt]);
    }
  }
  float* sp = stbuf + ((size_t)((b * 4 + h) * 64 + c)) * 8192;
#pragma unroll
  for (int vt = 0; vt < 8; vt++) {
    int v = vt * 16 + (lane & 15), d = wave * 16 + (lane >> 4) * 4;
    *(float4*)(sp + v * 64 + d) = make_float4(acc[vt][0], acc[vt][1], acc[vt][2], acc[vt][3]);
  }
}
__device__ __forceinline__ void gla_scan_job(const P& p, int job) {
  float* stbuf = (float*)(p.H + (size_t)T_TOK * PROJ0_LD * 2);
  const int e = job * 256 + ltid();
  const int bh = e >> 13, vd = e & 8191, d = e & 63;
  float* sp = stbuf + (size_t)bh * 64 * 8192 + vd;
  const float* dp = p.gdec + bh * 64 * 64 + d;
  float s = 0.f;
  for (int c0 = 0; c0 < 64; c0 += 16) {
    float ds[16], dc[16];
#pragma unroll
    for (int i = 0; i < 16; i++) { ds[i] = __builtin_nontemporal_load(&sp[(size_t)(c0 + i) * 8192]); dc[i] = dp[(c0 + i) * 64]; }
#pragma unroll
    for (int i = 0; i < 16; i++) { __builtin_nontemporal_store(s, &sp[(size_t)(c0 + i) * 8192]); s = dc[i] * s + ds[i]; }
  }
}
__device__ __forceinline__ void gla_out_job(const P& p, int job, char* smc) {
  const u16* proj = (const u16*)p.H;
  const float* stbuf = (const float*)(p.H + (size_t)T_TOK * PROJ0_LD * 2);
  const int h = job & 3, c = (job >> 2) & 63, b = job >> 8;
  const int t0 = b * SEQL + c * 64;
  float* bl = (float*)smc;
  u16* qin = (u16*)(smc + 16384);
  u16* kin = qin + 64 * GL_ST;
  u16* VtL = kin + 64 * GL_ST;
  float* dl = (float*)(VtL + 128 * GL_ST);
  float* w2s = dl + 1024;
  const int tid = ltid(), lane = tid & 63, wave = tid >> 6;
  __syncthreads();
  gla_cumdecay(p, proj, t0, h, bl, dl, w2s);
  {
    const int s = tid >> 2, ds = (tid & 3) * 16;
    const u16* qp = proj + (size_t)(t0 + s) * PROJ0_LD + h * 64 + ds;
    const u16* kp = qp + 256;
    float qf[16], kf[16];
    unpack8(*(const uint4*)qp, qf); unpack8(*(const uint4*)(qp + 8), qf + 8);
    unpack8(*(const uint4*)kp, kf); unpack8(*(const uint4*)(kp + 8), kf + 8);
#pragma unroll
    for (int i = 0; i < 16; i++) {
      float bb = bl[s * 64 + ds + i];
      qf[i] = qf[i] * 0.125f * __expf(bb);
      kf[i] = kf[i] * __expf(-bb);
    }
    *(bf16x8*)(qin + s * GL_ST + ds) = pack8(qf);
    *(bf16x8*)(qin + s * GL_ST + ds + 8) = pack8(qf + 8);
    *(bf16x8*)(kin + s * GL_ST + ds) = pack8(kf);
    *(bf16x8*)(kin + s * GL_ST + ds + 8) = pack8(kf + 8);
    const int vs = (tid & 3) * 32;
    const u16* vp = proj + (size_t)(t0 + s) * PROJ0_LD + 512 + h * 128 + vs;
#pragma unroll
    for (int i = 0; i < 4; i++) {
      uint4 u = *(const uint4*)(vp + i * 8);
      VtL[(vs + i * 8 + 0) * GL_ST + s] = (u16)(u.x & 0xffff); VtL[(vs + i * 8 + 1) * GL_ST + s] = (u16)(u.x >> 16);
      VtL[(vs + i * 8 + 2) * GL_ST + s] = (u16)(u.y & 0xffff); VtL[(vs + i * 8 + 3) * GL_ST + s] = (u16)(u.y >> 16);
      VtL[(vs + i * 8 + 4) * GL_ST + s] = (u16)(u.z & 0xffff); VtL[(vs + i * 8 + 5) * GL_ST + s] = (u16)(u.z >> 16);
      VtL[(vs + i * 8 + 6) * GL_ST + s] = (u16)(u.w & 0xffff); VtL[(vs + i * 8 + 7) * GL_ST + s] = (u16)(u.w >> 16);
    }
  }
  __syncthreads();
  f32x4 S[4];
#pragma unroll
  for (int i = 0; i < 4; i++) S[i] = (f32x4){0.f, 0.f, 0.f, 0.f};
  bf16x8 qf0 = *(const bf16x8*)(qin + (wave * 16 + (lane & 15)) * GL_ST + (lane >> 4) * 8);
  bf16x8 qf1 = *(const bf16x8*)(qin + (wave * 16 + (lane & 15)) * GL_ST + 32 + (lane >> 4) * 8);
#pragma unroll
  for (int si = 0; si < 4; si++) {
    if (si <= wave) {
      bf16x8 k0 = *(const bf16x8*)(kin + (si * 16 + (lane & 15)) * GL_ST + (lane >> 4) * 8);
      bf16x8 k1 = *(const bf16x8*)(kin + (si * 16 + (lane & 15)) * GL_ST + 32 + (lane >> 4) * 8);
      S[si] = MFMA16(k0, qf0, S[si]);
      S[si] = MFMA16(k1, qf1, S[si]);
      if (si == wave) {
#pragma unroll
        for (int r = 0; r < 4; r++)
          if (((lane >> 4) * 4 + r) > (lane & 15)) S[si][r] = 0.f;
      }
    }
  }
  f32x4 O[8];
#pragma unroll
  for (int i = 0; i < 8; i++) O[i] = (f32x4){0.f, 0.f, 0.f, 0.f};
#pragma unroll
  for (int kb = 0; kb < 2; kb++) {
    union { bf16x8 v; unsigned u[4]; } pb;
    pb.u[0] = pack2(S[2 * kb][0], S[2 * kb][1]); pb.u[1] = pack2(S[2 * kb][2], S[2 * kb][3]);
    pb.u[2] = pack2(S[2 * kb + 1][0], S[2 * kb + 1][1]); pb.u[3] = pack2(S[2 * kb + 1][2], S[2 * kb + 1][3]);
#pragma unroll
    for (int vt = 0; vt < 8; vt++) {
      union { bf16x8 v; uint2 h[2]; } va;
      const u16* vr = VtL + (vt * 16 + (lane & 15)) * GL_ST + kb * 32 + (lane >> 4) * 4;
      va.h[0] = *(const uint2*)vr;
      va.h[1] = *(const uint2*)(vr + 16);
      O[vt] = MFMA16(va.v, pb.v, O[vt]);
    }
  }
  const float* sp = stbuf + ((size_t)((b * 4 + h) * 64 + c)) * 8192;
#pragma unroll
  for (int vt = 0; vt < 8; vt++) {
    const float* sr = sp + (vt * 16 + (lane & 15)) * 64 + (lane >> 4) * 8;
    float f[8];
    const f32x4 n0_ = __builtin_nontemporal_load((const f32x4*)sr), n1_ = __builtin_nontemporal_load((const f32x4*)(sr + 4));
    float4 a0 = make_float4(n0_[0], n0_[1], n0_[2], n0_[3]), a1 = make_float4(n1_[0], n1_[1], n1_[2], n1_[3]);
    f[0] = a0.x; f[1] = a0.y; f[2] = a0.z; f[3] = a0.w; f[4] = a1.x; f[5] = a1.y; f[6] = a1.z; f[7] = a1.w;
    O[vt] = MFMA16(pack8(f), qf0, O[vt]);
    { const f32x4 m0_ = __builtin_nontemporal_load((const f32x4*)(sr + 32)), m1_ = __builtin_nontemporal_load((const f32x4*)(sr + 36));
      a0 = make_float4(m0_[0], m0_[1], m0_[2], m0_[3]); a1 = make_float4(m1_[0], m1_[1], m1_[2], m1_[3]); }
    f[0] = a0.x; f[1] = a0.y; f[2] = a0.z; f[3] = a0.w; f[4] = a1.x; f[5] = a1.y; f[6] = a1.z; f[7] = a1.w;
    O[vt] = MFMA16(pack8(f), qf1, O[vt]);
  }
  float ss = 0.f;
#pragma unroll
  for (int vt = 0; vt < 8; vt++)
#pragma unroll
    for (int r = 0; r < 4; r++) ss += O[vt][r] * O[vt][r];
  ss = xadd32(xadd16(ss));
  const float sc = rsqrtf(ss * (1.f / 128.f) + 1e-6f);
  const int tok = t0 + wave * 16 + (lane & 15);
#pragma unroll
  for (int vt = 0; vt < 8; vt++) {
    const int v = vt * 16 + (lane >> 4) * 4;
    float gt[4];
    unpack4(*(const uint2*)(proj + (size_t)tok * PROJ0_LD + 1024 + h * 128 + v), gt);
    float4 ng = *(const float4*)(p.gla_ng + h * 128 + v);
    float o0 = O[vt][0] * sc * ng.x * (gt[0] * sigmoidf_(gt[0]));
    float o1 = O[vt][1] * sc * ng.y * (gt[1] * sigmoidf_(gt[1]));
    float o2 = O[vt][2] * sc * ng.z * (gt[2] * sigmoidf_(gt[2]));
    float o3 = O[vt][3] * sc * ng.w * (gt[3] * sigmoidf_(gt[3]));
    *(uint2*)(p.A + (size_t)tok * 1024 + h * 128 + v) = pack4(o0, o1, o2, o3);
  }
}

__device__ __forceinline__ void s5_scan_job(const P& p, int job, float* sm) {
  const float* sloc = (const float*)p.B;
  u16* hin = p.B + (size_t)8 * 1024 * 1024;
  const int tid = ltid(), n = tid & 63, seg = tid >> 6;
  const int g = job & 31, b = job >> 5;
  const float delta = expf(p.s5_ls[g]);
  const float lr = fminf(p.s5_lre[g * 64 + n], -1e-4f), li = p.s5_lim[g * 64 + n];
  float sn, cs;
  sincosf(16.f * delta * li, &sn, &cs);
  const float ea = expf(16.f * delta * lr);
  const float mr = ea * cs, mi = ea * sn;
  float* segR = sm;
  float* segI = sm + 256;
  __syncthreads();
  const size_t base = ((size_t)((b * 256 + seg * 64) * 32 + g)) * 128 + n;
  float hr = 0.f, hi = 0.f;
  for (int c0 = 0; c0 < 64; c0 += 16) {
    float sr[16], si[16];
#pragma unroll
    for (int i = 0; i < 16; i++) { sr[i] = sloc[base + (size_t)(c0 + i) * 4096]; si[i] = sloc[base + (size_t)(c0 + i) * 4096 + 64]; }
#pragma unroll
    for (int i = 0; i < 16; i++) {
      const float nr = mr * hr - mi * hi + sr[i], ni = mr * hi + mi * hr + si[i];
      hr = nr; hi = ni;
    }
  }
  segR[seg * 64 + n] = hr; segI[seg * 64 + n] = hi;
  float pr = mr, pi = mi;
#pragma unroll
  for (int q = 0; q < 6; q++) { const float t = pr * pr - pi * pi; pi = 2.f * pr * pi; pr = t; }
  __syncthreads();
  hr = 0.f; hi = 0.f;
  for (int s2 = 0; s2 < seg; s2++) {
    const float nr = pr * hr - pi * hi + segR[s2 * 64 + n], ni = pr * hi + pi * hr + segI[s2 * 64 + n];
    hr = nr; hi = ni;
  }
  for (int c0 = 0; c0 < 64; c0 += 16) {
    float sr[16], si[16];
#pragma unroll
    for (int i = 0; i < 16; i++) { sr[i] = sloc[base + (size_t)(c0 + i) * 4096]; si[i] = sloc[base + (size_t)(c0 + i) * 4096 + 64]; }
#pragma unroll
    for (int i = 0; i < 16; i++) {
      const size_t o = base + (size_t)(c0 + i) * 4096;
      hin[o] = f2bf(hr); hin[o + 64] = f2bf(hi);
      const float nr = mr * hr - mi * hi + sr[i], ni = mr * hi + mi * hr + si[i];
      hr = nr; hi = ni;
    }
  }
}

#define AK_ST 264
#define AV_ST 40
__device__ __forceinline__ void attn_job(const P& p, int job, u16* sm) {
  const int qt = job & 63, h = (job >> 6) & 3, b = job >> 8;
  const int tid = ltid(), lane = tid & 63, wave = tid >> 6;
  const int tok = b * SEQL + qt * 64 + wave * 16 + (lane & 15);
  u16* Ks = sm;
  u16* Vs = sm + 32 * AK_ST;
  const u16* qp = p.B + (size_t)tok * 1024 + h * 256 + (lane >> 4) * 8;
  bf16x8 qf[8];
#pragma unroll
  for (int kb = 0; kb < 8; kb++) qf[kb] = *(const bf16x8*)(qp + kb * 32);
  f32x4 O[16];
#pragma unroll
  for (int i = 0; i < 16; i++) O[i] = (f32x4){0.f, 0.f, 0.f, 0.f};
  float mrun = -1e30f, lrun = 0.f;
  const int krow = tid >> 5, kch = (tid & 31) * 8;
  const int vrow = tid >> 2, vch = (tid & 3) * 8;
  const u16* kg = p.Kp + (size_t)(b * 256 + krow) * 1024 + h * 256 + kch;
  const u16* vg = p.Vt + ((size_t)((b * 4 + h) * 256 + vrow)) * 256 + vch;
  bf16x8 rk[4], rv[4];
#pragma unroll
  for (int i = 0; i < 4; i++) { rk[i] = *(const bf16x8*)(kg + (size_t)(8 * i) * 1024); rv[i] = *(const bf16x8*)(vg + (size_t)(64 * i) * 256); }
#pragma unroll 1
  for (int nb2 = 0; nb2 < 8; nb2++) {
    __syncthreads();
#pragma unroll
    for (int i = 0; i < 4; i++) {
      *(bf16x8*)(Ks + (krow + 8 * i) * AK_ST + kch) = rk[i];
      *(bf16x8*)(Vs + (vrow + 64 * i) * AV_ST + vch) = rv[i];
    }
    __syncthreads();
    if (nb2 + 1 < 8) {
#pragma unroll
      for (int i = 0; i < 4; i++) {
        rk[i] = *(const bf16x8*)(kg + (size_t)((nb2 + 1) * 32 + 8 * i) * 1024);
        rv[i] = *(const bf16x8*)(vg + (size_t)(64 * i) * 256 + (nb2 + 1) * 32);
      }
    }
    f32x4 S0 = (f32x4){0.f, 0.f, 0.f, 0.f}, S1 = (f32x4){0.f, 0.f, 0.f, 0.f};
    const u16* kr = Ks + (lane & 15) * AK_ST + (lane >> 4) * 8;
#pragma unroll
    for (int kb = 0; kb < 8; kb++) {
      const bf16x8 k0 = *(const bf16x8*)(kr + kb * 32);
      const bf16x8 k1 = *(const bf16x8*)(kr + 16 * AK_ST + kb * 32);
      S0 = MFMA16(k0, qf[kb], S0);
      S1 = MFMA16(k1, qf[kb], S1);
    }
    float mx = fmaxf(fmaxf(fmaxf(S0[0], S0[1]), fmaxf(S0[2], S0[3])), fmaxf(fmaxf(S1[0], S1[1]), fmaxf(S1[2], S1[3])));
    mx = xmax32(xmax16(mx));
    const float mnew = fmaxf(mrun, mx);
    const float alpha = __expf((mrun - mnew) * 0.0625f);
    mrun = mnew;
    float e[8];
#pragma unroll
    for (int r = 0; r < 4; r++) { e[r] = __expf((S0[r] - mnew) * 0.0625f); e[4 + r] = __expf((S1[r] - mnew) * 0.0625f); }
    float ps = (e[0] + e[1]) + (e[2] + e[3]) + (e[4] + e[5]) + (e[6] + e[7]);
    ps = xadd32(xadd16(ps));
    lrun = lrun * alpha + ps;
    const bf16x8 pf = pack8(e);
    const u16* vr = Vs + (lane & 15) * AV_ST + (lane >> 4) * 4;
#pragma unroll
    for (int dt = 0; dt < 16; dt++) {
      union { bf16x8 v; uint2 hh[2]; } va;
      va.hh[0] = *(const uint2*)(vr + dt * 16 * AV_ST);
      va.hh[1] = *(const uint2*)(vr + dt * 16 * AV_ST + 16);
      f32x4 o = O[dt];
      o[0] *= alpha; o[1] *= alpha; o[2] *= alpha; o[3] *= alpha;
      O[dt] = MFMA16(va.v, pf, o);
    }
  }
  const float inv = 1.f / lrun;
  u16* op = p.A + (size_t)tok * 1024 + h * 256 + (lane >> 4) * 4;
#pragma unroll
  for (int dt = 0; dt < 16; dt++) *(uint2*)(op + dt * 16) = pack4(O[dt][0] * inv, O[dt][1] * inv, O[dt][2] * inv, O[dt][3] * inv);
}

#define PROJ1_LD 2816
#define RW_TC 16
struct RwBuf { float dec[RW_TC][64], kk[RW_TC][64], kka[RW_TC][64], kp[RW_TC][64], wr[RW_TC][64], v[RW_TC][16], c[RW_TC][2]; };
__device__ __forceinline__ void rwkv_scan_job(const P& p, int job, char* smc) {
  const u16* proj = (const u16*)p.H;
  const u16* ldb = (const u16*)(p.H + (size_t)T_TOK * PROJ1_LD * 2);
  const u16* ab = ldb + (size_t)T_TOK * 512;
  const int rq = job & 3, h = (job >> 2) & 7, b = job >> 5;
  RwBuf* bufs = (RwBuf*)smc;
  float* ybuf = (float*)(smc + 2 * sizeof(RwBuf));
  const int tid = ltid(), lane = tid & 63, wave = tid >> 6;
  const int jg = tid & 15, tl = tid >> 4;
  const int col = h * 64 + jg * 4;
  float mur[4], muk[4], muv[4], kkc[4], kac[4], rkc[4];
#pragma unroll
  for (int i = 0; i < 4; i++) {
    mur[i] = p.mu[col + i]; muk[i] = p.mu[576 + col + i]; muv[i] = p.mu[1088 + col + i];
    kkc[i] = p.k_k[col + i]; kac[i] = p.k_a[col + i]; rkc[i] = p.r_k[col + i];
  }
  uint2 g_r, g_rp, g_k, g_kp, g_v, g_vp, g_ld, g_a;
  size_t g_t = 0;
  bool g_first = false;
  auto gload = [&](int c) {
    const int l = c * RW_TC + tl;
    const size_t t = (size_t)b * SEQL + l;
    const u16* pr = proj + t * PROJ1_LD + col;
    g_r = *(const uint2*)pr; g_k = *(const uint2*)(pr + 576); g_v = *(const uint2*)(pr + 1088);
    const u16* pp = pr - ((l > 0) ? PROJ1_LD : 0);
    g_rp = *(const uint2*)pp; g_kp = *(const uint2*)(pp + 576); g_vp = *(const uint2*)(pp + 1088);
    g_first = (l == 0);
    g_ld = *(const uint2*)(ldb + t * 512 + col);
    g_a = *(const uint2*)(ab + t * 512 + col);
    g_t = t;
  };
  auto stage = [&](RwBuf& bf) {
    float r[4], rp[4], k[4], kpv[4], v[4], vp[4], ld[4], a[4];
    unpack4(g_r, r); unpack4(g_rp, rp); unpack4(g_k, k); unpack4(g_kp, kpv); unpack4(g_v, v); unpack4(g_vp, vp);
    if (g_first) {
#pragma unroll
      for (int i = 0; i < 4; i++) { rp[i] = 0.f; kpv[i] = 0.f; vp[i] = 0.f; }
    }
    unpack4(g_ld, ld); unpack4(g_a, a);
    float kkr[4], kpr[4], rs[4], vs[4], ss = 0.f;
#pragma unroll
    for (int i = 0; i < 4; i++) {
      rs[i] = r[i] + (rp[i] - r[i]) * mur[i];
      float ks = k[i] + (kpv[i] - k[i]) * muk[i];
      vs[i] = v[i] + (vp[i] - v[i]) * muv[i];
      kkr[i] = ks * kkc[i];
      ss += kkr[i] * kkr[i];
      kpr[i] = ks * (1.f + (a[i] - 1.f) * kac[i]);
    }
    ss = sum16(ss);
    const float inv = rsqrtf(fmaxf(ss, 1e-24f));
    float c1 = 0.f, c2 = 0.f, c3 = 0.f;
    float dk[4], kk4[4], kka4[4], wr4[4];
#pragma unroll
    for (int i = 0; i < 4; i++) {
      kk4[i] = kkr[i] * inv;
      kka4[i] = kk4[i] * a[i];
      dk[i] = __expf(ld[i]);
      wr4[i] = dk[i] * rs[i];
      c1 += kka4[i] * rs[i];
      c2 += kpr[i] * rs[i];
      c3 += kpr[i] * rs[i] * rkc[i];
    }
    c1 = sum16(c1); c2 = sum16(c2); c3 = sum16(c3);
    *(float4*)&bf.dec[tl][jg * 4] = make_float4(dk[0], dk[1], dk[2], dk[3]);
    *(float4*)&bf.kk[tl][jg * 4] = make_float4(kk4[0], kk4[1], kk4[2], kk4[3]);
    *(float4*)&bf.kka[tl][jg * 4] = make_float4(kka4[0], kka4[1], kka4[2], kka4[3]);
    *(float4*)&bf.kp[tl][jg * 4] = make_float4(kpr[0], kpr[1], kpr[2], kpr[3]);
    *(float4*)&bf.wr[tl][jg * 4] = make_float4(wr4[0], wr4[1], wr4[2], wr4[3]);
    if ((jg >> 2) == rq) *(float4*)&bf.v[tl][(jg & 3) * 4] = make_float4(vs[0], vs[1], vs[2], vs[3]);
    if (jg == 0) { bf.c[tl][0] = c1; bf.c[tl][1] = c2; if (rq == 0) p.c3buf[(size_t)g_t * 8 + h] = c3; }
  };
  __syncthreads();
  gload(0);
  stage(bufs[0]);
  __syncthreads();
  typedef float v2f __attribute__((ext_vector_type(2)));
  v2f Sa = {0.f, 0.f}, Sb = {0.f, 0.f};
  const int il = wave * 4 + (lane >> 4);
  const float m0 = ((lane & 15) == 0) ? 1.f : 0.f;
  const bool b3 = lane & 8, b2 = lane & 4, b1 = lane & 2, b0 = lane & 1;
  const int NCH = SEQL / RW_TC;
  for (int c = 0; c < NCH; c++) {
    const bool more = (c + 1) < NCH;
    if (more) gload(c + 1);
    const RwBuf& bf = bufs[c & 1];
    float* yb = ybuf + (c & 1) * 256;
    float yv[RW_TC];
    float4 o_dec[3], o_kk[3], o_kka[3], o_kp[3], o_wr[3];
    float o_vi[3];
    float2 o_c[3];
#define RW_LD(slot, tt)                                                                          \
    { o_dec[slot] = *(const float4*)&bf.dec[tt][jg * 4]; o_kk[slot] = *(const float4*)&bf.kk[tt][jg * 4];   \
      o_kka[slot] = *(const float4*)&bf.kka[tt][jg * 4]; o_kp[slot] = *(const float4*)&bf.kp[tt][jg * 4];   \
      o_wr[slot] = *(const float4*)&bf.wr[tt][jg * 4]; o_vi[slot] = bf.v[tt][il]; o_c[slot] = *(const float2*)&bf.c[tt][0]; }
    RW_LD(0, 0);
    RW_LD(1, 1);
#pragma unroll
    for (int t = 0; t < RW_TC; t++) {
      if (t + 2 < RW_TC) RW_LD((t + 2) % 3, t + 2);
      const float4 dec = o_dec[t % 3], kk = o_kk[t % 3], kka = o_kka[t % 3], kp = o_kp[t % 3], wr = o_wr[t % 3];
      const float vi = o_vi[t % 3], c1 = o_c[t % 3].x, c2 = o_c[t % 3].y;
      const v2f kk0 = {kk.x, kk.y}, kk1 = {kk.z, kk.w}, wr0 = {wr.x, wr.y}, wr1 = {wr.z, wr.w};
      v2f ps = Sa * kk0 + Sb * kk1;
      v2f py = Sa * wr0 + Sb * wr1;
      float sa = ps.x + ps.y, yd = py.x + py.y;
      sa = sum16(sa);
      yv[t] = yd + m0 * (vi * c2 - sa * c1);
      const v2f dec0 = {dec.x, dec.y}, dec1 = {dec.z, dec.w}, ka0 = {kka.x, kka.y}, ka1 = {kka.z, kka.w},
                kp0 = {kp.x, kp.y}, kp1 = {kp.z, kp.w};
      const v2f sav = {sa, sa}, viv = {vi, vi};
      Sa = Sa * dec0 - sav * ka0 + viv * kp0;
      Sb = Sb * dec1 - sav * ka1 + viv * kp1;
    }
#undef RW_LD
    {
      float r8[8], r4[4], r2[2];
#pragma unroll
      for (int i = 0; i < 8; i++) {
        const float keep = b3 ? yv[i + 8] : yv[i], send = b3 ? yv[i] : yv[i + 8];
        r8[i] = keep + dppf<0x128>(send);
      }
#pragma unroll
      for (int i = 0; i < 4; i++) {
        const float keep = b2 ? r8[i + 4] : r8[i], send = b2 ? r8[i] : r8[i + 4];
        r4[i] = keep + dppf<0x141>(send);
      }
#pragma unroll
      for (int i = 0; i < 2; i++) {
        const float keep = b1 ? r4[i + 2] : r4[i], send = b1 ? r4[i] : r4[i + 2];
        r2[i] = keep + dppf<0x4E>(send);
      }
      const float keep = b0 ? r2[1] : r2[0], send = b0 ? r2[0] : r2[1];
      const float ysum = keep + dppf<0xB1>(send);
      yb[(lane & 15) * 16 + il] = ysum;
    }
    if (more) stage(bufs[(c + 1) & 1]);
    __syncthreads();
    {
      const int tt = tid >> 4, ii = tid & 15;
      const size_t t = (size_t)b * SEQL + c * RW_TC + tt;
      p.A[t * 1024 + h * 64 + rq * 16 + ii] = f2bf(yb[tt * 16 + ii]);
    }
  }
}

#define LRU_LB 16
__device__ __forceinline__ void lru_scan_job(const P& p, int job, float* sm) {
  const u16* proj = (const u16*)p.H;
  const u16* lab = p.B;
  const u16* bbuf = p.B + (size_t)T_TOK * 512;
  const int lane = ltid() & 63, seg = ltid() >> 6;
  const int b = job >> 3, ch = (job & 7) * 64 + lane;
  const size_t tb = (size_t)b * SEQL + seg * 1024;
  float* segP = sm;
  float* segH = sm + 256;
  __syncthreads();
  float P_ = 1.f, hl = 0.f;
  {
    u16 la_n[LRU_LB], b_n[LRU_LB];
#pragma unroll
    for (int i = 0; i < LRU_LB; i++) { la_n[i] = lab[(tb + i) * 512 + ch]; b_n[i] = bbuf[(tb + i) * 512 + ch]; }
    for (int l0 = 0; l0 < 1024; l0 += LRU_LB) {
      u16 la_c[LRU_LB], b_c[LRU_LB];
#pragma unroll
      for (int i = 0; i < LRU_LB; i++) { la_c[i] = la_n[i]; b_c[i] = b_n[i]; }
      if (l0 + LRU_LB < 1024) {
#pragma unroll
        for (int i = 0; i < LRU_LB; i++) { la_n[i] = lab[(tb + l0 + LRU_LB + i) * 512 + ch]; b_n[i] = bbuf[(tb + l0 + LRU_LB + i) * 512 + ch]; }
      }
#pragma unroll
      for (int i = 0; i < LRU_LB; i++) {
        const float a = __expf(bf2f(la_c[i]));
        hl = a * hl + bf2f(b_c[i]);
        P_ *= a;
      }
    }
  }
  segP[seg * 64 + lane] = P_;
  segH[seg * 64 + lane] = hl;
  __syncthreads();
  float hs = 0.f;
  for (int s2 = 0; s2 < seg; s2++) hs = segP[s2 * 64 + lane] * hs + segH[s2 * 64 + lane];
  {
    u16 la_n[LRU_LB], b_n[LRU_LB], g_n[LRU_LB];
#pragma unroll
    for (int i = 0; i < LRU_LB; i++) {
      la_n[i] = lab[(tb + i) * 512 + ch]; b_n[i] = bbuf[(tb + i) * 512 + ch]; g_n[i] = proj[(tb + i) * PROJ1_LD + 2304 + ch];
    }
    for (int l0 = 0; l0 < 1024; l0 += LRU_LB) {
      u16 la_c[LRU_LB], b_c[LRU_LB], g_c[LRU_LB];
#pragma unroll
      for (int i = 0; i < LRU_LB; i++) { la_c[i] = la_n[i]; b_c[i] = b_n[i]; g_c[i] = g_n[i]; }
      if (l0 + LRU_LB < 1024) {
#pragma unroll
        for (int i = 0; i < LRU_LB; i++) {
          const size_t t = tb + l0 + LRU_LB + i;
          la_n[i] = lab[t * 512 + ch]; b_n[i] = bbuf[t * 512 + ch]; g_n[i] = proj[t * PROJ1_LD + 2304 + ch];
        }
      }
#pragma unroll
      for (int i = 0; i < LRU_LB; i++) {
        const float a = __expf(bf2f(la_c[i]));
        hs = a * hs + bf2f(b_c[i]);
        const float g = bf2f(g_c[i]);
        const float u2 = 1.5957691216057308f * (g + 0.044715f * g * g * g);
        const float ge = g * frcp(1.f + __expf(-u2));
        p.A[(tb + l0 + i) * 1024 + 512 + ch] = f2bf(hs * ge);
      }
    }
  }
}

__device__ __forceinline__ void rw_shift8(const u16* proj, const float* mu, int m, int col, float* f) {
  const u16* pr = proj + (size_t)m * PROJ1_LD + col;
  float a[8], b[8];
  unpack8(*(const uint4*)pr, a);
  const bool hasprev = (m & (SEQL - 1)) != 0;
  unpack8(*(const uint4*)(pr - (hasprev ? PROJ1_LD : 0)), b);
  const float pz = hasprev ? 1.f : 0.f;
#pragma unroll
  for (int i = 0; i < 8; i++) b[i] *= pz;
  float4 m0 = *(const float4*)(mu + col), m1 = *(const float4*)(mu + col + 4);
  float mm[8] = {m0.x, m0.y, m0.z, m0.w, m1.x, m1.y, m1.z, m1.w};
#pragma unroll
  for (int i = 0; i < 8; i++) f[i] = a[i] + (b[i] - a[i]) * mm[i];
}
__device__ __forceinline__ void rw_shift4(const u16* proj, const float* mu, int m, int col, float* f) {
  const u16* pr = proj + (size_t)m * PROJ1_LD + col;
  float a[4], b[4];
  unpack4(*(const uint2*)pr, a);
  const bool hasprev = (m & (SEQL - 1)) != 0;
  unpack4(*(const uint2*)(pr - (hasprev ? PROJ1_LD : 0)), b);
  const float pz = hasprev ? 1.f : 0.f;
  b[0] *= pz; b[1] *= pz; b[2] *= pz; b[3] *= pz;
  float4 m0 = *(const float4*)(mu + col);
  f[0] = a[0] + (b[0] - a[0]) * m0.x; f[1] = a[1] + (b[1] - a[1]) * m0.y;
  f[2] = a[2] + (b[2] - a[2]) * m0.z; f[3] = a[3] + (b[3] - a[3]) * m0.w;
}

struct AL5 {
  const u16* pj; int g;
  __device__ __forceinline__ bf16x8 operator()(int m, int k, int) const {
    return *(const bf16x8*)(pj + (size_t)(m * 16 + (k >> 4)) * PROJ0_LD + 1552 + g * 16 + (k & 15));
  }
};
struct ALw { const u16* pj; const float* mu;
  __device__ __forceinline__ bf16x8 operator()(int m, int k, int) const {
    float f[8]; rw_shift8(pj, mu, m, 512 + k, f);
#pragma unroll
    for (int i = 0; i < 8; i++) f[i] = fast_tanh(f[i]);
    return pack8(f); } };
struct ALa { const u16* pj; const float* mu;
  __device__ __forceinline__ bf16x8 operator()(int m, int k, int) const {
    float f[8]; rw_shift8(pj, mu, m, 1600 + k, f); return pack8(f); } };
struct ALg { const u16* pj; const float* mu;
  __device__ __forceinline__ bf16x8 operator()(int m, int k, int) const {
    float f[8]; rw_shift8(pj, mu, m, 1664 + k, f);
#pragma unroll
    for (int i = 0; i < 8; i++) f[i] = sigmoidf_(f[i]);
    return pack8(f); } };
struct ALl { const u16* pj; const float* cw; const float* cb;
  __device__ __forceinline__ bf16x8 operator()(int m, int k, int nt) const {
    const int ch = nt * 64 + k;
    float acc[8];
    float4 b0 = *(const float4*)(cb + ch), b1 = *(const float4*)(cb + ch + 4);
    acc[0] = b0.x; acc[1] = b0.y; acc[2] = b0.z; acc[3] = b0.w; acc[4] = b1.x; acc[5] = b1.y; acc[6] = b1.z; acc[7] = b1.w;
    const int l = m & (SEQL - 1);
#pragma unroll
    for (int j = 0; j < 4; j++) {
      {
        const bool ok = (l - 3 + j) >= 0;
        const float z = ok ? 1.f : 0.f;
        float x[8];
        unpack8(*(const uint4*)(pj + (size_t)(m - (ok ? 3 - j : 0)) * PROJ1_LD + 1792 + ch), x);
        float4 w0 = *(const float4*)(cw + j * 512 + ch), w1 = *(const float4*)(cw + j * 512 + ch + 4);
        acc[0] += z * w0.x * x[0]; acc[1] += z * w0.y * x[1]; acc[2] += z * w0.z * x[2]; acc[3] += z * w0.w * x[3];
        acc[4] += z * w1.x * x[4]; acc[5] += z * w1.y * x[5]; acc[6] += z * w1.z * x[6]; acc[7] += z * w1.w * x[7];
      }
    }
    return pack8(acc); } };
struct EPlru {
  const u16* pj; u16* lab; u16* bb; const float* cw; const float* cb; const float* lb_a; const float* lb_x; const float* llam;
  __device__ __forceinline__ void operator()(f32x4 (&acc)[4][4], int mw, int nw, int lane, int nt) const {
    const int wn = (nw >> 6) & 1;
    uint2 xr[2][4][4];
#pragma unroll
    for (int q = 0; q < 2; q++) {
      const int ch = nt * 64 + wn * 32 + q * 16 + (lane >> 4) * 4;
#pragma unroll
      for (int j = 0; j < 4; j++) {
        const int m = mw + j * 16 + (lane & 15);
        const int l = m & (SEQL - 1);
#pragma unroll
        for (int d = 0; d < 4; d++)
          xr[q][j][d] = *(const uint2*)(pj + (size_t)(m - (l >= d ? d : 0)) * PROJ1_LD + 1792 + ch);
      }
    }
#pragma unroll
    for (int q = 0; q < 2; q++) {
      const int ch = nt * 64 + wn * 32 + q * 16 + (lane >> 4) * 4;
      const float4 ba = *(const float4*)(lb_a + ch), bx = *(const float4*)(lb_x + ch), lm = *(const float4*)(llam + ch);
      const float4 cbv = *(const float4*)(cb + ch);
      const float4 w0 = *(const float4*)(cw + ch), w1 = *(const float4*)(cw + 512 + ch), w2 = *(const float4*)(cw + 1024 + ch),
                   w3 = *(const float4*)(cw + 1536 + ch);
      const float sp[4] = {softplusf_(-lm.x), softplusf_(-lm.y), softplusf_(-lm.z), softplusf_(-lm.w)};
      const float bav[4] = {ba.x, ba.y, ba.z, ba.w}, bxv[4] = {bx.x, bx.y, bx.z, bx.w};
      const float wd[4][4] = {{w3.x, w3.y, w3.z, w3.w}, {w2.x, w2.y, w2.z, w2.w}, {w1.x, w1.y, w1.z, w1.w}, {w0.x, w0.y, w0.z, w0.w}};
#pragma unroll
      for (int j = 0; j < 4; j++) {
        const int m = mw + j * 16 + (lane & 15);
        const int l = m & (SEQL - 1);
        float xc[4] = {cbv.x, cbv.y, cbv.z, cbv.w};
#pragma unroll
        for (int d = 0; d < 4; d++) {
          float x[4];
          unpack4(xr[q][j][d], x);
          const float z = (l >= d) ? 1.f : 0.f;
          xc[0] += z * wd[d][0] * x[0]; xc[1] += z * wd[d][1] * x[1]; xc[2] += z * wd[d][2] * x[2]; xc[3] += z * wd[d][3] * x[3];
        }
        float la[4], bo[4];
#pragma unroll
        for (int r = 0; r < 4; r++) {
          const float rg = sigmoidf_(acc[2 * q][j][r] + bav[r]);
          const float ig = sigmoidf_(acc[2 * q + 1][j][r] + bxv[r]);
          la[r] = -8.f * rg * sp[r];
          const float mult = __builtin_amdgcn_sqrtf(fmaxf(1.f - __expf(2.f * la[r]), 0.f));
          bo[r] = mult * ig * xc[r];
        }
        *(uint2*)(lab + (size_t)m * 512 + ch) = pack4(la[0], la[1], la[2], la[3]);
        *(uint2*)(bb + (size_t)m * 512 + ch) = pack4(bo[0], bo[1], bo[2], bo[3]);
      }
    }
  }
};
struct EPfin {
  const u16* pj; const float* mu; u16* A; const float* c3buf; const float* ln_g; const float* ln_b;
  __device__ __forceinline__ void operator()(f32x4 (&acc)[4][4], int mw, int nw, int lane, int) const {
    const int hh = nw >> 6;
#pragma unroll
    for (int j = 0; j < 4; j++) {
      const int m = mw + j * 16 + (lane & 15);
      float y[16], sum = 0.f;
      const float c3 = c3buf[(size_t)m * 8 + hh];
#pragma unroll
      for (int i = 0; i < 4; i++) {
        const int ch = nw + i * 16 + (lane >> 4) * 4;
        unpack4(*(const uint2*)(A + (size_t)m * 1024 + ch), y + i * 4);
        sum += y[i * 4] + y[i * 4 + 1] + y[i * 4 + 2] + y[i * 4 + 3];
      }
      sum = xadd32(xadd16(sum));
      const float mean = sum * (1.f / 64.f);
      float var = 0.f;
#pragma unroll
      for (int i = 0; i < 16; i++) var += (y[i] - mean) * (y[i] - mean);
      var = xadd32(xadd16(var));
      const float rstd = rsqrtf(var * (1.f / 64.f) + 64e-5f);
#pragma unroll
      for (int i = 0; i < 4; i++) {
        const int ch = nw + i * 16 + (lane >> 4) * 4;
        float vs[4];
        rw_shift4(pj, mu, m, 1088 + ch, vs);
        float4 lg = *(const float4*)(ln_g + ch), lb = *(const float4*)(ln_b + ch);
        float o0 = ((y[i * 4 + 0] - mean) * rstd * lg.x + lb.x + c3 * vs[0]) * acc[i][j][0];
        float o1 = ((y[i * 4 + 1] - mean) * rstd * lg.y + lb.y + c3 * vs[1]) * acc[i][j][1];
        float o2 = ((y[i * 4 + 2] - mean) * rstd * lg.z + lb.z + c3 * vs[2]) * acc[i][j][2];
        float o3 = ((y[i * 4 + 3] - mean) * rstd * lg.w + lb.w + c3 * vs[3]) * acc[i][j][3];
        *(uint2*)(A + (size_t)m * 1024 + ch) = pack4(o0, o1, o2, o3);
      }
    }
  }
};

#define XB_TMO      128
#define XB_XCNT(j)  (256  + 64 * (j))
#define XB_XSUB(j)  (1280 + 64 * (j))
#define XB_XGEN(j)  (2304 + 64 * (j))
#define XB_TOP      3328
#define XB_TOPGEN   3392
#define XCD_BAR_WORDS 3456
#define XB_SPIN_CAP (1u << 22)
#define LAS __attribute__((address_space(3)))
__device__ __forceinline__ unsigned xb_ld(unsigned* p)              { return __hip_atomic_load(p, __ATOMIC_RELAXED, __HIP_MEMORY_SCOPE_AGENT); }
__device__ __forceinline__ unsigned xb_add(unsigned* p, unsigned v) { return __hip_atomic_fetch_add(p, v, __ATOMIC_RELAXED, __HIP_MEMORY_SCOPE_AGENT); }
__device__ __forceinline__ unsigned xb_xcc_id() { return (unsigned)__builtin_amdgcn_s_getreg((3 << 11) | 20) & 0xFu; }
#define XB_SPIN(cond, bar) do { unsigned _sp = 0; while (cond) { __builtin_amdgcn_s_sleep(1); \
    if ((++_sp & 255u) == 0u) { if (xb_ld(&(bar)[XB_TMO])) break; if (_sp > XB_SPIN_CAP) { atomicAdd(&(bar)[XB_TMO], 1u); break; } } } } while (0)
struct XcdBarrier { unsigned* bar; unsigned x; volatile LAS unsigned* st; };
__device__ __forceinline__ XcdBarrier xcd_barrier_post(unsigned* bar, volatile LAS unsigned* st) {
  XcdBarrier b; b.bar = bar; b.x = xb_xcc_id(); b.st = st;
  if (threadIdx.x == 0) (void)xb_add(&bar[XB_XCNT(b.x)], 1u);
  return b;
}
__device__ __forceinline__ void xcd_barrier_complete(unsigned* bar, unsigned x, unsigned& nloc, unsigned& nx) {
  const unsigned G = gridDim.x * gridDim.y * gridDim.z;
  unsigned sum, cnt, mine, sp = 0u;
  for (;;) {
    sum = 0u; cnt = 0u; mine = 0u;
#pragma unroll
    for (unsigned j = 0; j < 16; ++j) { const unsigned c = xb_ld(&bar[XB_XCNT(j)]); sum += c; cnt += (c > 0u) ? 1u : 0u; mine = (j == x) ? c : mine; }
    if (sum == G) break;
    __builtin_amdgcn_s_sleep(1);
    if ((++sp & 255u) == 0u) { if (xb_ld(&bar[XB_TMO])) break; if (sp > XB_SPIN_CAP) { atomicAdd(&bar[XB_TMO], 1u); break; } }
  }
  nloc = mine > 0u ? mine : 1u; nx = cnt > 0u ? cnt : 1u;
}
__device__ __forceinline__ void xcd_barrier(const XcdBarrier& b) {
  asm volatile("s_waitcnt vmcnt(0)" ::: "memory");
  __syncthreads();
  if (threadIdx.x == 0) {
    unsigned* bar = b.bar;
    __builtin_amdgcn_s_waitcnt(0);
    unsigned nloc = b.st[0], nx = b.st[1];
    if (nloc == 0u) { xcd_barrier_complete(bar, b.x, nloc, nx); b.st[0] = nloc; b.st[1] = nx; }
    const unsigned old = xb_add(&bar[XB_XSUB(b.x)], 1u);
    const unsigned gen = old / nloc;
    if (old + 1u == (gen + 1u) * nloc) {
      __builtin_amdgcn_fence(__ATOMIC_RELEASE, "agent");
      asm volatile("s_waitcnt vmcnt(0)" ::: "memory");
      const unsigned og = xb_add(&bar[XB_TOP], 1u);
      const unsigned tg = og / nx;
      if (og + 1u == (tg + 1u) * nx) xb_add(&bar[XB_TOPGEN], 1u);
      else XB_SPIN(xb_ld(&bar[XB_TOPGEN]) == tg, bar);
      __builtin_amdgcn_fence(__ATOMIC_ACQUIRE, "agent");
      xb_add(&bar[XB_XGEN(b.x)], 1u);
      asm volatile("s_waitcnt vmcnt(0)" ::: "memory");
    } else {
      XB_SPIN(xb_ld(&bar[XB_XGEN(b.x)]) == gen, bar);
      __builtin_amdgcn_fence(__ATOMIC_ACQUIRE, "agent");
      asm volatile("s_waitcnt vmcnt(0)" ::: "memory");
    }
  }
  __syncthreads();
}

__device__ __forceinline__ void kv_tile(const P& p, int t, u16* smu) {
  auto fk = [=] __device__(int m, int n, const f32x4& a, int) {
    *(uint2*)(p.Kp + (size_t)m * 1024 + n) = pack4(a[0], a[1], a[2], a[3]);
  };
  auto fv = [=] __device__(int m, int n, const f32x4& a, int) {
    const int bb = m >> 8, mm = m & 255, hh = n >> 8, d = n & 255;
    u16* vp = p.Vt + ((size_t)((bb * 4 + hh) * 256 + d)) * 256 + mm;
    vp[0] = f2bf(a[0]); vp[256] = f2bf(a[1]); vp[512] = f2bf(a[2]); vp[768] = f2bf(a[3]);
  };
  if (t < 64) gemm_tile(ALbf{p.memn, 1024}, p.Wk, 1024, (t & 7) * 128, (t >> 3) * 128, 0, EPgen<decltype(fk)>{fk}, smu);
  else gemm_tile(ALbf{p.memn, 1024}, p.Wv, 1024, (t & 7) * 128, ((t - 64) >> 3) * 128, 0, EPgen<decltype(fv)>{fv}, smu);
}

__global__ void __launch_bounds__(NTHR, 2) mega(P p, int ph_lo, int ph_hi) {
  cg::grid_group grid = cg::this_grid();
  __shared__ __attribute__((aligned(1024))) char smem[73728];
  __shared__ uint4 xb_words;
  if (threadIdx.x == 0) xb_words = make_uint4(0u, 0u, 0u, 0u);
  __syncthreads();
  XcdBarrier xb; xb.bar = p.bar; xb.x = 0; xb.st = (volatile LAS unsigned*)&xb_words;
  if (blockIdx.x == 0) { for (int i = threadIdx.x; i < XCD_BAR_WORDS; i += NTHR) p.bar[i] = 0u; }
  const int nb = gridDim.x, nw = nb * 4;
  u16* smu = (u16*)smem;
  const u16* proj = (const u16*)p.H;

  for (int si = ph_lo; si < ph_hi; ++si) {
    const int ph = p.seq[si];
    if (si > ph_lo) { if (si == ph_lo + 1) { grid.sync(); xb = xcd_barrier_post(p.bar, (volatile LAS unsigned*)&xb_words); } else xcd_barrier(xb); }
    int bid = blockIdx.x;
    asm volatile("" : "+s"(bid));
    const int tid = ltid();
    const int gw = bid * 4 + (tid >> 6);
    const int layer = ph >= 15 ? 1 : 0;
    const float* ng = p.norm_gain + layer * 7 * 1024;
    switch (ph) {
      case 0: {
        if (bid < 32) s5_precompute(p, bid, (float*)smem);
        else if (bid < 40) lru_weight_job(p, bid - 32);
        if (bid >= 32) transpose_jobs(p.tab0, p.ntab0, p.ntiles0, (float*)smem, bid - 32, nb - 32);
        norm_rows(p.mem, p.norm_gain + 6 * 1024, p.memn, 1024, gw, nw);
        norm_rows(p.x, p.norm_gain, p.A, T_TOK, gw, nw);
      } break;
      case 1: {
        auto f = [=] __device__(int m, int n, const f32x4& a, int) {
          if (n < 2064) *(uint2*)((u16*)p.H + (size_t)m * PROJ0_LD + n) = pack4(a[0], a[1], a[2], a[3]);
        };
        auto f8 = [=] __device__(int m, int n, const f32x4& a, const f32x4& b) {
          *(uint4*)((u16*)p.H + (size_t)m * PROJ0_LD + n) = pack8v(a, b);
        };
        gemm_big_jobs(ALbf{p.A, 1024}, p.Win0, 1024, 16, f8, smu, bid, nb);
        __syncthreads();
        for (int t = bid; t < 128; t += nb) gemm_tile(ALbf{p.A, 1024}, p.Win0, 1024, t * 128, 16 * 128, 16, EPgen<decltype(f)>{f}, smu);
      } break;
      case 2: {
        for (int j = bid; j < 1024; j += nb) gla_state_job(p, j, smem);
        __syncthreads();
        float* ybuf = (float*)(p.H + (size_t)T_TOK * PROJ0_LD * 2 + (size_t)32 * 1024 * 1024);
        float* sloc = (float*)p.B;
        for (int t = bid; t < 32 * 8 * 3; t += nb) {
          const int g = t / 24, r = t % 24, mt = r & 7, ntl = r >> 3;
          auto f = [=] __device__(int m, int n, const f32x4& a, int) {
            if (n < 256) *(float4*)(ybuf + (size_t)(m * 16 + (n >> 4)) * 512 + g * 16 + (n & 15)) = make_float4(a[0], a[1], a[2], a[3]);
            else *(float4*)(sloc + ((size_t)(m * 32 + g)) * 128 + (n - 256)) = make_float4(a[0], a[1], a[2], a[3]);
          };
          gemm_tile(AL5{proj, g}, p.S5W1 + (size_t)g * 384 * 256, 256, mt * 128, ntl * 128, ntl, EPgen<decltype(f)>{f}, smu);
        }
      } break;
      case 3: {
        for (int j = bid; j < 512; j += nb) gla_scan_job(p, j);
        for (int t = bid; t < 256; t += nb) {
          __syncthreads();
          if (t < 128) s5_scan_job(p, t, (float*)smem); else kv_tile(p, t - 128, smu);
        }
      } break;
      case 4: {
        for (int j = bid; j < 1024; j += nb) gla_out_job(p, j, smem);
        __syncthreads();
        float* ybuf = (float*)(p.H + (size_t)T_TOK * PROJ0_LD * 2 + (size_t)32 * 1024 * 1024);
        const u16* hin = p.B + (size_t)8 * 1024 * 1024;
        for (int t = bid; t < 32 * 8 * 2; t += nb) {
          const int g = t >> 4, r = t & 15, mt = r & 7, ntl = r >> 3;
          auto f = [=] __device__(int m, int n, const f32x4& a, int) {
            const int tok = m * 16 + (n >> 4), ch = g * 16 + (n & 15);
            float* yp = ybuf + (size_t)tok * 512 + ch;
            float4 y0 = *(const float4*)yp;
            float u[4];
            unpack4(*(const uint2*)(proj + (size_t)tok * PROJ0_LD + 1552 + ch), u);
            float4 d = *(const float4*)(p.s5_d + ch);
            *(float4*)yp = make_float4(y0.x + a[0] + d.x * u[0], y0.y + a[1] + d.y * u[1], y0.z + a[2] + d.z * u[2], y0.w + a[3] + d.w * u[3]);
          };
          gemm_tile(ALbf{hin + (size_t)g * 128, 32 * 128}, p.S5W2 + (size_t)g * 256 * 128, 128, mt * 128, ntl * 128, ntl,
                    EPgen<decltype(f)>{f}, smu);
        }
      } break;
      case 5: {
        const float* ybuf = (const float*)(p.H + (size_t)T_TOK * PROJ0_LD * 2 + (size_t)32 * 1024 * 1024);
        auto f = [=] __device__(int m, int n, const f32x4& a, int) {
          float4 y = *(const float4*)(ybuf + (size_t)m * 512 + n);
          float4 bg = *(const float4*)(p.s5_bglu + n);
          *(uint2*)(p.A + (size_t)m * 1024 + 512 + n) =
              pack4(gelu_tanh(y.x) * sigmoidf_(a[0] + bg.x), gelu_tanh(y.y) * sigmoidf_(a[1] + bg.y),
                    gelu_tanh(y.z) * sigmoidf_(a[2] + bg.z), gelu_tanh(y.w) * sigmoidf_(a[3] + bg.w));
        };
        gemm_jobs(ALf32{ybuf, 512}, p.Wglu, 512, 128, 4, EPgen<decltype(f)>{f}, smu, bid, nb);
      } break;
      case 6: case 19: {
        auto f = [=] __device__(int m, int n, const f32x4& a, int) {
          *(uint2*)(p.B + (size_t)m * 1024 + n) = pack4(a[0], a[1], a[2], a[3]);
        };
        auto f8 = [=] __device__(int m, int n, const f32x4& a, const f32x4& b) { *(uint4*)(p.B + (size_t)m * 1024 + n) = pack8v(a, b); };
        gemm_big_jobs(ALbf{p.A, 1024}, ph == 6 ? p.Wout0 : p.Wout1, 1024, 8, f8, smu, bid, nb);
      } break;
      case 7: case 20:
        if (ph == 20 && bid < 128) kv_tile(p, bid, smu);
        resid_norm(ph == 7 ? p.x : p.out, p.B, ng + 1 * 1024, ng + 2 * 1024, p.out, p.A, gw, nw);
        break;
      case 8: case 21: {
        auto f = [=] __device__(int m, int n, const f32x4& a, int) {
          *(uint2*)(p.B + (size_t)m * 1024 + n) = pack4(a[0], a[1], a[2], a[3]);
        };
        auto f8 = [=] __device__(int m, int n, const f32x4& a, const f32x4& b) { *(uint4*)(p.B + (size_t)m * 1024 + n) = pack8v(a, b); };
        gemm_big_jobs(ALbf{p.A, 1024}, p.Wq, 1024, 8, f8, smu, bid, nb);
      } break;
      case 9: case 22:
        for (int j = bid; j < 1024; j += nb) attn_job(p, j, smu);
        break;
      case 10: case 23: {
        auto f = [=] __device__(int m, int n, const f32x4& a, int) {
          *(uint2*)(p.B + (size_t)m * 1024 + n) = pack4(a[0], a[1], a[2], a[3]);
        };
        auto f8 = [=] __device__(int m, int n, const f32x4& a, const f32x4& b) { *(uint4*)(p.B + (size_t)m * 1024 + n) = pack8v(a, b); };
        gemm_big_jobs(ALbf{p.A, 1024}, p.Wo, 1024, 8, f8, smu, bid, nb);
      } break;
      case 11: case 24:
        resid_norm(p.out, p.B, ng + 3 * 1024, ng + 4 * 1024, p.out, p.A, gw, nw);
        break;
      case 12: case 25: {
        u16* hid = (u16*)p.H;
        auto f = [=] __device__(int m, int n, const f32x4& a, int) {
          float r0 = fmaxf(a[0], 0.f), r1 = fmaxf(a[1], 0.f), r2 = fmaxf(a[2], 0.f), r3 = fmaxf(a[3], 0.f);
          *(uint2*)(hid + (size_t)m * 4096 + n) = pack4(r0 * r0, r1 * r1, r2 * r2, r3 * r3);
        };
        auto f8 = [=] __device__(int m, int n, const f32x4& a, const f32x4& b) {
          f32x4 ra, rb;
#pragma unroll
          for (int q = 0; q < 4; q++) { float x = fmaxf(a[q], 0.f), y = fmaxf(b[q], 0.f); ra[q] = x * x; rb[q] = y * y; }
          *(uint4*)(hid + (size_t)m * 4096 + n) = pack8v(ra, rb);
        };
        gemm_big_jobs(ALbf{p.A, 1024}, p.W1, 1024, 32, f8, smu, bid, nb);
      } break;
      case 13: case 26: {
        auto f = [=] __device__(int m, int n, const f32x4& a, int) {
          *(uint2*)(p.B + (size_t)m * 1024 + n) = pack4(a[0], a[1], a[2], a[3]);
        };
        auto f8 = [=] __device__(int m, int n, const f32x4& a, const f32x4& b) { *(uint4*)(p.B + (size_t)m * 1024 + n) = pack8v(a, b); };
        gemm_big_jobs(ALbf{(const u16*)p.H, 4096}, p.W2, 4096, 8, f8, smu, bid, nb);
      } break;
      case 14:
        resid_norm(p.out, p.B, ng + 5 * 1024, p.norm_gain + 7 * 1024, p.out, p.A, gw, nw);
        break;
      case 27:
        resid_norm(p.out, p.B, ng + 5 * 1024, nullptr, p.out, nullptr, gw, nw);
        break;
      case 15: {
        norm_rows(p.mem, p.norm_gain + 13 * 1024, p.memn, 1024, gw, nw);
        auto f = [=] __device__(int m, int n, const f32x4& a, int) {
          *(uint2*)((u16*)p.H + (size_t)m * PROJ1_LD + n) = pack4(a[0], a[1], a[2], a[3]);
        };
        auto f8 = [=] __device__(int m, int n, const f32x4& a, const f32x4& b) { *(uint4*)((u16*)p.H + (size_t)m * PROJ1_LD + n) = pack8v(a, b); };
        gemm_big_jobs(ALbf{p.A, 1024}, p.Win1, 1024, 22, f8, smu, bid, nb);
      } break;
      case 16: {
        u16* ldb = (u16*)(p.H + (size_t)T_TOK * PROJ1_LD * 2);
        u16* ab = ldb + (size_t)T_TOK * 512;
        u16* lab = p.B;
        u16* ib = p.B + (size_t)T_TOK * 512;
        auto fw = [=] __device__(int m, int n, const f32x4& a, int) {
          float4 w0 = *(const float4*)(p.w0 + n);
          float o[4] = {w0.x + a[0], w0.y + a[1], w0.z + a[2], w0.w + a[3]};
#pragma unroll
          for (int i = 0; i < 4; i++) { float wv = -softplusf_(-o[i]) - 0.5f; o[i] = -__expf(wv); }
          *(uint2*)(ldb + (size_t)m * 512 + n) = pack4(o[0], o[1], o[2], o[3]);
        };
        auto fa = [=] __device__(int m, int n, const f32x4& a, int) {
          float4 a0 = *(const float4*)(p.a0 + n);
          *(uint2*)(ab + (size_t)m * 512 + n) = pack4(sigmoidf_(a0.x + a[0]), sigmoidf_(a0.y + a[1]), sigmoidf_(a0.z + a[2]), sigmoidf_(a0.w + a[3]));
        };
        for (int t = bid; t < 512 + 512 + 1024; t += nb) {
          if (t < 512) gemm_tile(ALw{proj, p.mu}, p.Rw2t, 64, (t & 127) * 128, (t >> 7) * 128, 0, EPgen<decltype(fw)>{fw}, smu);
          else if (t < 1024) { int tt = t - 512; gemm_tile(ALa{proj, p.mu}, p.Ra2t, 64, (tt & 127) * 128, (tt >> 7) * 128, 0, EPgen<decltype(fa)>{fa}, smu); }
          else { int tt = t - 1024; gemm_tile(ALl{proj, p.conv_w, p.conv_b}, p.Lwt, 64, (tt & 127) * 128, (tt >> 7) * 128, tt >> 7, EPlru{proj, lab, ib, p.conv_w, p.conv_b, p.lb_a, p.lb_x, p.llam}, smu); }
        }
      } break;
      case 17: {
        if (bid < 128) rwkv_scan_job(p, bid, smem);
        else if (bid < 160) lru_scan_job(p, bid - 128, (float*)smem);
        else transpose_jobs(p.tab1, p.ntab1, p.ntiles1, (float*)smem, bid - 160, nb - 160);
      } break;
      case 18: {
        gemm_jobs(ALg{proj, p.mu}, p.Rg2t, 128, 128, 4, EPfin{proj, p.mu, p.A, p.c3buf, p.ln_g, p.ln_b}, smu, bid, nb);
      } break;
      default: break;
    }
  }
}

static inline size_t al256(size_t x) { return (x + 255) & ~(size_t)255; }

extern "C" void kernel_launch(void* const* d_in, const int* in_sizes, int n_in, void* d_out, int out_size,
                              void* d_ws, size_t ws_size, hipStream_t stream) {
  static int grid_blocks = 0;
  if (!grid_blocks) {
    int dev = 0, cus = 0, per_cu = 0;
    hipGetDevice(&dev);
    hipDeviceGetAttribute(&cus, hipDeviceAttributeMultiprocessorCount, dev);
    hipOccupancyMaxActiveBlocksPerMultiprocessor(&per_cu, mega, NTHR, 0);
    if (per_cu > 2) per_cu = 2;
    if (per_cu < 1) per_cu = 1;
    grid_blocks = cus * per_cu;
  }
  P p;
  memset(&p, 0, sizeof(p));
  const float** fin = (const float**)d_in;
  p.x = fin[0]; p.mem = fin[1]; p.norm_gain = fin[2]; p.wq = fin[3]; p.wk = fin[4]; p.wv = fin[5]; p.wo = fin[6];
  p.w1 = fin[7]; p.w2 = fin[8]; p.ab_w_in = fin[9]; p.gla_w2 = fin[10]; p.gla_bd = fin[11]; p.gla_ng = fin[12];
  p.s5_lre = fin[13]; p.s5_lim = fin[14]; p.s5_ls = fin[15]; p.s5_bre = fin[16]; p.s5_bim = fin[17]; p.s5_cre = fin[18];
  p.s5_cim = fin[19]; p.s5_d = fin[20]; p.s5_wglu = fin[21]; p.s5_bglu = fin[22]; p.ab_w_out = fin[23];
  p.cd_w_in = fin[24]; p.mu = fin[25]; p.w0 = fin[26]; p.rw2 = fin[27]; p.a0 = fin[28]; p.ra2 = fin[29]; p.rg2 = fin[30];
  p.k_k = fin[31]; p.k_a = fin[32]; p.r_k = fin[33]; p.ln_g = fin[34]; p.ln_b = fin[35]; p.conv_w = fin[36];
  p.conv_b = fin[37]; p.lw_a = fin[38]; p.lb_a = fin[39]; p.lw_x = fin[40]; p.lb_x = fin[41]; p.llam = fin[42];
  p.cd_w_out = fin[43];
  p.out = (float*)d_out;
  char* w = (char*)d_ws;
  size_t off = 0;
  auto alloc = [&](size_t bytes) { char* r = w + off; off = al256(off + bytes); return r; };
  const size_t MB = 1024 * 1024;
  p.Wq = (u16*)alloc(2 * MB); p.Wk = (u16*)alloc(2 * MB); p.Wv = (u16*)alloc(2 * MB); p.Wo = (u16*)alloc(2 * MB);
  p.W1 = (u16*)alloc(8 * MB); p.W2 = (u16*)alloc(8 * MB);
  p.Win0 = (u16*)alloc((size_t)2176 * 1024 * 2); p.Wout0 = (u16*)alloc(2 * MB); p.Wglu = (u16*)alloc(512 * 512 * 2);
  p.S5W1 = (u16*)alloc((size_t)32 * 384 * 256 * 2); p.S5W2 = (u16*)alloc((size_t)32 * 256 * 128 * 2);
  p.Win1 = (u16*)alloc((size_t)2816 * 1024 * 2); p.Wout1 = (u16*)alloc(2 * MB);
  p.Rw2t = (u16*)alloc(512 * 64 * 2); p.Ra2t = (u16*)alloc(512 * 64 * 2); p.Rg2t = (u16*)alloc(512 * 128 * 2);
  p.Lwt = (u16*)alloc(8 * 128 * 64 * 2);
  p.memn = (u16*)alloc(2 * MB); p.Kp = (u16*)alloc(2 * MB); p.Vt = (u16*)alloc(2 * MB);
  p.gdec = (float*)alloc(16 * 64 * 64 * 4);
  p.c3buf = (float*)alloc((size_t)T_TOK * 8 * 4);
  p.bar = (unsigned*)alloc(XCD_BAR_WORDS * 4);
  p.A = (u16*)alloc(32 * MB); p.B = (u16*)alloc(32 * MB);
  p.H = alloc((size_t)T_TOK * PROJ0_LD * 2 + 64 * MB);
  if (off > ws_size) { fprintf(stderr, "workspace too small: need %zu have %zu\n", off, ws_size); }
  int nt = 0, tiles = 0;
  auto add = [&](TDesc* tab, const float* src, u16* dst, int K, int N, int Npad) {
    tab[nt].src = src; tab[nt].dst = dst; tab[nt].K = K; tab[nt].N = N; tab[nt].Npad = Npad; tab[nt].t0 = tiles;
    tiles += (K / 64) * (Npad / 64); nt++;
  };
  add(p.tab0, p.ab_w_in, p.Win0, 1024, 2064, 2176);
  add(p.tab0, p.w1, p.W1, 1024, 4096, 4096);
  add(p.tab0, p.w2, p.W2, 4096, 1024, 1024);
  add(p.tab0, p.wq, p.Wq, 1024, 1024, 1024);
  add(p.tab0, p.wk, p.Wk, 1024, 1024, 1024);
  add(p.tab0, p.wv, p.Wv, 1024, 1024, 1024);
  add(p.tab0, p.wo, p.Wo, 1024, 1024, 1024);
  add(p.tab0, p.ab_w_out, p.Wout0, 1024, 1024, 1024);
  add(p.tab0, p.s5_wglu, p.Wglu, 512, 512, 512);
  add(p.tab0, p.cd_w_in, p.Win1, 1024, 2816, 2816);
  add(p.tab0, p.cd_w_out, p.Wout1, 1024, 1024, 1024);
  add(p.tab0, p.rw2, p.Rw2t, 64, 512, 512);
  add(p.tab0, p.ra2, p.Ra2t, 64, 512, 512);
  add(p.tab0, p.rg2, p.Rg2t, 128, 512, 512);
  p.ntab0 = nt; p.ntiles0 = tiles;
  nt = 0; tiles = 0;
  add(p.tab1, p.w1 + (size_t)1024 * 4096, p.W1, 1024, 4096, 4096);
  add(p.tab1, p.w2 + (size_t)1024 * 4096, p.W2, 4096, 1024, 1024);
  add(p.tab1, p.wq + MB, p.Wq, 1024, 1024, 1024);
  add(p.tab1, p.wk + MB, p.Wk, 1024, 1024, 1024);
  add(p.tab1, p.wv + MB, p.Wv, 1024, 1024, 1024);
  add(p.tab1, p.wo + MB, p.Wo, 1024, 1024, 1024);
  p.ntab1 = nt; p.ntiles1 = tiles;

#ifdef MULTI_LAUNCH
  for (int ph = 0; ph < 28; ph++) {
    int lo = ph, hi = ph + 1;
    hipLaunchKernelGGL(mega, dim3(grid_blocks), dim3(NTHR), 0, stream, p, lo, hi);
  }
#else
  {
    int n = 0;
    for (int ph = 0; ph < 28; ph++) {
      p.seq[n++] = (unsigned char)ph;
#ifdef PROBE_MASK
      if ((PROBE_MASK >> ph) & 1u) p.seq[n++] = (unsigned char)ph;
#endif
    }
    p.nseq = n;
  }
  int lo = 0, hi = p.nseq;
  void* args[] = {&p, &lo, &hi};
  hipError_t e = hipLaunchCooperativeKernel((void*)mega, dim3(grid_blocks), dim3(NTHR), args, 0, stream);
  if (e != hipSuccess) fprintf(stderr, "coop launch failed: %s (grid %d)\n", hipGetErrorString(e), grid_blocks);
#endif
}
```

```cpp
#include <hip/hip_runtime.h>
#include <hip/hip_cooperative_groups.h>
#include <cstdio>
#include <cstdint>
#include <cstring>
namespace cg = cooperative_groups;

typedef unsigned short u16;
typedef __attribute__((ext_vector_type(8))) short bf16x8;
typedef __attribute__((ext_vector_type(4))) float f32x4;

#define T_TOK 16384
#define SEQL 4096
#define NTHR 256

typedef float float2v_ __attribute__((ext_vector_type(2)));
typedef __bf16 bf16x2v_ __attribute__((ext_vector_type(2)));
__device__ __forceinline__ unsigned pack2(float lo, float hi) {
  float2v_ f = {lo, hi};
  bf16x2v_ b = __builtin_convertvector(f, bf16x2v_);
  return __builtin_bit_cast(unsigned, b);
}
__device__ __forceinline__ float bflo(unsigned u) { return __uint_as_float(u << 16); }
__device__ __forceinline__ float bfhi(unsigned u) { return __uint_as_float(u & 0xffff0000u); }
__device__ __forceinline__ float bf2f(u16 h) { return __uint_as_float(((unsigned)h) << 16); }
__device__ __forceinline__ u16 f2bf(float f) { return (u16)(pack2(f, 0.f) & 0xffffu); }
__device__ __forceinline__ void unpack4(uint2 u, float* f) { f[0] = bflo(u.x); f[1] = bfhi(u.x); f[2] = bflo(u.y); f[3] = bfhi(u.y); }
__device__ __forceinline__ uint2 pack4(float a, float b, float c, float d) { return make_uint2(pack2(a, b), pack2(c, d)); }
__device__ __forceinline__ bf16x8 pack8(const float* f) {
  union { bf16x8 v; unsigned u[4]; } r;
  r.u[0] = pack2(f[0], f[1]); r.u[1] = pack2(f[2], f[3]); r.u[2] = pack2(f[4], f[5]); r.u[3] = pack2(f[6], f[7]);
  return r.v;
}
__device__ __forceinline__ void unpack8(uint4 u, float* f) {
  f[0] = bflo(u.x); f[1] = bfhi(u.x); f[2] = bflo(u.y); f[3] = bfhi(u.y);
  f[4] = bflo(u.z); f[5] = bfhi(u.z); f[6] = bflo(u.w); f[7] = bfhi(u.w);
}
__device__ __forceinline__ float frcp(float x) { return __builtin_amdgcn_rcpf(x); }
__device__ __forceinline__ float sigmoidf_(float x) { return frcp(1.f + __expf(-x)); }
__device__ __forceinline__ float softplusf_(float z) { return fmaxf(z, 0.f) + __logf(1.f + __expf(-fabsf(z))); }
__device__ __forceinline__ float logsigmoidf_(float x) { return fminf(x, 0.f) - __logf(1.f + __expf(-fabsf(x))); }
__device__ __forceinline__ float fast_tanh(float x) { return 1.f - 2.f * frcp(1.f + __expf(2.f * x)); }
__device__ __forceinline__ float gelu_tanh(float x) {
  const float u2 = 1.5957691216057308f * (x + 0.044715f * x * x * x);
  return x * frcp(1.f + __expf(-u2));
}
__device__ __forceinline__ float xadd16(float x) { unsigned a = __float_as_uint(x); auto r = __builtin_amdgcn_permlane16_swap(a, a, false, false); return __uint_as_float(r[0]) + __uint_as_float(r[1]); }
__device__ __forceinline__ float xadd32(float x) { unsigned a = __float_as_uint(x); auto r = __builtin_amdgcn_permlane32_swap(a, a, false, false); return __uint_as_float(r[0]) + __uint_as_float(r[1]); }
__device__ __forceinline__ float xmax16(float x) { unsigned a = __float_as_uint(x); auto r = __builtin_amdgcn_permlane16_swap(a, a, false, false); return fmaxf(__uint_as_float(r[0]), __uint_as_float(r[1])); }
__device__ __forceinline__ float xmax32(float x) { unsigned a = __float_as_uint(x); auto r = __builtin_amdgcn_permlane32_swap(a, a, false, false); return fmaxf(__uint_as_float(r[0]), __uint_as_float(r[1])); }
template <int CTRL>
__device__ __forceinline__ float dppf(float x) {
  return __int_as_float(__builtin_amdgcn_mov_dpp(__float_as_int(x), CTRL, 0xf, 0xf, true));
}
__device__ __forceinline__ float sum16(float x) {
  x += dppf<0xB1>(x);
  x += dppf<0x4E>(x);
  x += dppf<0x141>(x);
  x += dppf<0x140>(x);
  return x;
}
__device__ __forceinline__ int ltid() { int t = threadIdx.x; asm volatile("" : "+v"(t)); return t; }
__device__ __forceinline__ float wave_sum(float v) {
  v = sum16(v);
  return xadd32(xadd16(v));
}
#define MFMA16(a, b, c) __builtin_amdgcn_mfma_f32_16x16x32_bf16((a), (b), (c), 0, 0, 0)

struct TDesc { const float* src; u16* dst; int K, N, Npad, t0; };
#define MAXT 40
struct P {
  const float *x, *mem, *norm_gain, *wq, *wk, *wv, *wo, *w1, *w2;
  const float *ab_w_in, *gla_w2, *gla_bd, *gla_ng, *s5_lre, *s5_lim, *s5_ls, *s5_bre, *s5_bim, *s5_cre, *s5_cim, *s5_d,
      *s5_wglu, *s5_bglu, *ab_w_out;
  const float *cd_w_in, *mu, *w0, *rw2, *a0, *ra2, *rg2, *k_k, *k_a, *r_k, *ln_g, *ln_b, *conv_w, *conv_b, *lw_a, *lb_a,
      *lw_x, *lb_x, *llam, *cd_w_out;
  float* out;
  u16 *Wq, *Wk, *Wv, *Wo, *W1, *W2;
  u16 *Win0, *Wout0, *Wglu, *S5W1, *S5W2, *Win1, *Wout1, *Rw2t, *Ra2t, *Rg2t, *Lwt;
  u16 *memn, *Kp, *Vt;
  u16 *A, *B;
  char* H;
  float* gdec;
  float* c3buf;
  unsigned* bar;
  TDesc tab0[MAXT];
  TDesc tab1[8];
  int ntab0, ntiles0, ntab1, ntiles1;
  int nseq, pad_;
  unsigned char seq[64];
};

#define GST 32
#define GSW(row, q) ((((q) ^ ((0 - (((row) & 15) >> 2)) & 3))) * 8)
template <class AL, class EP>
__device__ __forceinline__ void gemm_tile(const AL& al, const u16* __restrict__ Wt, int K, int m0, int n0, int nt,
                                          const EP& ep, u16* sm) {
  const int tid = ltid(), lane = tid & 63, wave = tid >> 6;
  const int wm = wave >> 1, wn = wave & 1;
  u16* As = sm;
  u16* Bs = sm + 2 * 128 * GST;
  const int lr0 = tid >> 2, lkc = (tid & 3) * 8;
  const int lsw = GSW(lr0, tid & 3);
  const int rsw = GSW(lane & 15, lane >> 4);
  f32x4 acc[4][4];
#pragma unroll
  for (int i = 0; i < 4; i++)
#pragma unroll
    for (int j = 0; j < 4; j++) acc[i][j] = (f32x4){0.f, 0.f, 0.f, 0.f};
  const u16* wp0 = Wt + (size_t)(n0 + lr0) * K + lkc;
  const u16* wp1 = Wt + (size_t)(n0 + lr0 + 64) * K + lkc;
  const int nk = K >> 5;
  bf16x8 e0, e1, e2, e3;
  bf16x8 o0, o1, o2, o3;
#define G_LOAD(r0, r1, r2, r3, kt_)                                                    \
  { const int k0_ = (kt_) * 32; r0 = al(m0 + lr0, k0_ + lkc, nt); r1 = al(m0 + lr0 + 64, k0_ + lkc, nt); \
    r2 = *(const bf16x8*)(wp0 + k0_); r3 = *(const bf16x8*)(wp1 + k0_); }
#define G_STORE(r0, r1, r2, r3, buf_)                                                  \
  { u16* An_ = As + (buf_) * 128 * GST; u16* Bn_ = Bs + (buf_) * 128 * GST;             \
    *(bf16x8*)(An_ + lr0 * GST + lsw) = r0; *(bf16x8*)(An_ + (lr0 + 64) * GST + lsw) = r1; \
    *(bf16x8*)(Bn_ + lr0 * GST + lsw) = r2; *(bf16x8*)(Bn_ + (lr0 + 64) * GST + lsw) = r3; }
#define G_COMPUTE(buf_)                                                                \
  { const u16* Ac_ = As + (buf_) * 128 * GST; const u16* Bc_ = Bs + (buf_) * 128 * GST; \
    bf16x8 wf[4], xf[4];                                                               \
    _Pragma("unroll") for (int i = 0; i < 4; i++) wf[i] = *(const bf16x8*)(Bc_ + (wn * 64 + i * 16 + (lane & 15)) * GST + rsw); \
    _Pragma("unroll") for (int i = 0; i < 4; i++) xf[i] = *(const bf16x8*)(Ac_ + (wm * 64 + i * 16 + (lane & 15)) * GST + rsw); \
    _Pragma("unroll") for (int i = 0; i < 4; i++)                                      \
      _Pragma("unroll") for (int j = 0; j < 4; j++) acc[i][j] = MFMA16(wf[i], xf[j], acc[i][j]); }
  G_LOAD(e0, e1, e2, e3, 0);
  G_LOAD(o0, o1, o2, o3, 1);
  G_STORE(e0, e1, e2, e3, 0);
  if (nk > 2) G_LOAD(e0, e1, e2, e3, 2);
  __syncthreads();
  for (int kt = 0; kt < nk; kt += 2) {
    G_COMPUTE(0);
    G_STORE(o0, o1, o2, o3, 1);
    if (kt + 3 < nk) G_LOAD(o0, o1, o2, o3, kt + 3);
    __syncthreads();
    G_COMPUTE(1);
    if (kt + 2 < nk) {
      G_STORE(e0, e1, e2, e3, 0);
      if (kt + 4 < nk) G_LOAD(e0, e1, e2, e3, kt + 4);
    }
    __syncthreads();
  }
#undef G_LOAD
#undef G_STORE
#undef G_COMPUTE
  ep(acc, m0 + wm * 64, n0 + wn * 64, lane, nt);
}

struct ALbf {
  const u16* A; int lda;
  __device__ __forceinline__ bf16x8 operator()(int m, int k, int) const { return *(const bf16x8*)(A + (size_t)m * lda + k); }
};
#define GB_STAGE_EL (384 * GST)
#define WAIT_V(n) asm volatile("s_waitcnt vmcnt(%0)" ::"n"(n) : "memory")
#define RAW_BARRIER() do { asm volatile("s_waitcnt lgkmcnt(0)" ::: "memory"); __builtin_amdgcn_s_barrier(); } while (0)
typedef __attribute__((address_space(3))) unsigned lds_u32;
__device__ __forceinline__ void gb_issue(const u16* ga, const u16* gw, size_t a64, size_t w64, int ko, u16* __restrict__ wr, int wave) {
#pragma unroll
  for (int i = 0; i < 4; i++)
    __builtin_amdgcn_global_load_lds((const unsigned*)(ga + i * a64 + ko), (lds_u32*)(wr + (i * 4 + wave) * 512), 16, 0, 0);
#pragma unroll
  for (int i = 0; i < 2; i++)
    __builtin_amdgcn_global_load_lds((const unsigned*)(gw + i * w64 + ko), (lds_u32*)(wr + 256 * GST + (i * 4 + wave) * 512), 16, 0, 0);
}
__device__ __forceinline__ void gb_step(const u16* ga, const u16* gw, size_t a64, size_t w64, int ko, bool issue,
                                        const u16* __restrict__ rd, u16* __restrict__ wr, int wave, int wm, int wn, int lane, int rsw,
                                        f32x4 (&acc)[4][8]) {
  if (issue) {
#pragma unroll
    for (int i = 0; i < 4; i++)
      __builtin_amdgcn_global_load_lds((const unsigned*)(ga + i * a64 + ko), (lds_u32*)(wr + (i * 4 + wave) * 512), 16, 0, 0);
#pragma unroll
    for (int i = 0; i < 2; i++)
      __builtin_amdgcn_global_load_lds((const unsigned*)(gw + i * w64 + ko), (lds_u32*)(wr + 256 * GST + (i * 4 + wave) * 512), 16, 0, 0);
  }
  const unsigned rdb = (unsigned)(size_t)(__attribute__((address_space(3))) const char*)rd;
  const unsigned ab = rdb + (unsigned)(((wm * 128 + (lane & 15)) * GST + rsw) * 2);
  const int wr0 = wn * 64 + (((lane & 15) >> 2) << 3) + (lane & 3);
  const unsigned bb0 = rdb + (unsigned)((256 * GST + wr0 * GST + GSW(wr0, lane >> 4)) * 2);
  const unsigned bb1 = rdb + (unsigned)((256 * GST + (wr0 + 4) * GST + GSW(wr0 + 4, lane >> 4)) * 2);
  bf16x8 wf0, wf1, wf2, wf3, xf0, xf1, xf2, xf3, xf4, xf5, xf6, xf7;
#define DSR(dst, addr, off) asm volatile("ds_read_b128 %0, %1 offset:%2" : "=v"(dst) : "v"(addr), "n"(off) : "memory")
  DSR(wf0, bb0, 0); DSR(wf1, bb1, 0); DSR(wf2, bb0, 2048); DSR(wf3, bb1, 2048);
  DSR(xf0, ab, 0); DSR(xf1, ab, 1024); DSR(xf2, ab, 2048); DSR(xf3, ab, 3072);
  DSR(xf4, ab, 4096); DSR(xf5, ab, 5120); DSR(xf6, ab, 6144); DSR(xf7, ab, 7168);
#undef DSR
#define MM(j, xf)                                                                     \
  acc[0][j] = MFMA16(wf0, xf, acc[0][j]); acc[1][j] = MFMA16(wf1, xf, acc[1][j]);      \
  acc[2][j] = MFMA16(wf2, xf, acc[2][j]); acc[3][j] = MFMA16(wf3, xf, acc[3][j]);
  asm volatile("s_waitcnt lgkmcnt(7)" : "+v"(wf0), "+v"(wf1), "+v"(wf2), "+v"(wf3), "+v"(xf0) : : "memory");
  MM(0, xf0)
  asm volatile("s_waitcnt lgkmcnt(6)" : "+v"(xf1) : : "memory");
  MM(1, xf1)
  asm volatile("s_waitcnt lgkmcnt(5)" : "+v"(xf2) : : "memory");
  MM(2, xf2)
  asm volatile("s_waitcnt lgkmcnt(4)" : "+v"(xf3) : : "memory");
  MM(3, xf3)
  asm volatile("s_waitcnt lgkmcnt(3)" : "+v"(xf4) : : "memory");
  MM(4, xf4)
  asm volatile("s_waitcnt lgkmcnt(2)" : "+v"(xf5) : : "memory");
  MM(5, xf5)
  asm volatile("s_waitcnt lgkmcnt(1)" : "+v"(xf6) : : "memory");
  MM(6, xf6)
  asm volatile("s_waitcnt lgkmcnt(0)" : "+v"(xf7) : : "memory");
  MM(7, xf7)
#undef MM
}
template <class F>
__device__ __forceinline__ void gemm_big(const ALbf& al, const u16* __restrict__ Wt, int K, int m0, int n0, const F& f, u16* sm) {
  const int tid = ltid(), lane = tid & 63, wave = tid >> 6;
  const int wm = wave >> 1, wn = wave & 1;
  const int rsw = GSW(lane & 15, lane >> 4);
  f32x4 acc[4][8];
#pragma unroll
  for (int i = 0; i < 4; i++)
#pragma unroll
    for (int j = 0; j < 8; j++) acc[i][j] = (f32x4){0.f, 0.f, 0.f, 0.f};
  const int srow = lane >> 2;
  const int scol = ((lane & 3) ^ ((0 - (srow >> 2)) & 3)) * 8;
  const u16* ga = al.A + (size_t)(m0 + wave * 16 + srow) * al.lda + scol;
  const u16* gw = Wt + (size_t)(n0 + wave * 16 + srow) * K + scol;
  const size_t a64 = (size_t)64 * al.lda, w64 = (size_t)64 * K;
  const int nk = K >> 5;
  WAIT_V(0);
  gb_issue(ga, gw, a64, w64, 0, sm, wave);
  gb_issue(ga, gw, a64, w64, 32, sm + GB_STAGE_EL, wave);
  WAIT_V(6);
  RAW_BARRIER();
  int cur = 0;
  for (int kt = 0; kt < nk; ++kt) {
    const int nxt2 = (cur >= 1) ? cur - 1 : 2;
    gb_step(ga, gw, a64, w64, (kt + 2) * 32, kt + 2 < nk, sm + cur * GB_STAGE_EL, sm + nxt2 * GB_STAGE_EL, wave, wm, wn, lane, rsw, acc);
    if (kt + 2 < nk) WAIT_V(6); else WAIT_V(0);
    RAW_BARRIER();
    cur = (cur == 2) ? 0 : cur + 1;
  }
#pragma unroll
  for (int pq = 0; pq < 2; pq++)
#pragma unroll
    for (int j = 0; j < 8; j++)
      f(m0 + wm * 128 + j * 16 + (lane & 15), n0 + wn * 64 + pq * 32 + (lane >> 4) * 8, acc[2 * pq][j], acc[2 * pq + 1][j]);
}
__device__ __forceinline__ uint4 pack8v(const f32x4& a, const f32x4& b) {
  return make_uint4(pack2(a[0], a[1]), pack2(a[2], a[3]), pack2(b[0], b[1]), pack2(b[2], b[3]));
}
template <class F>
__device__ __forceinline__ void gemm_big_jobs(const ALbf& al, const u16* Wt, int K, int Nt, const F& f, u16* sm, int job0, int jstride) {
  for (int t = job0; t < 64 * Nt; t += jstride) gemm_big(al, Wt, K, (t & 63) * 256, (t >> 6) * 128, f, sm);
}

struct ALf32 {
  const float* A; int lda;
  __device__ __forceinline__ bf16x8 operator()(int m, int k, int) const {
    const float4* p = (const float4*)(A + (size_t)m * lda + k);
    float4 a = p[0], b = p[1];
    float f[8] = {a.x, a.y, a.z, a.w, b.x, b.y, b.z, b.w};
    return pack8(f);
  }
};
template <class F>
struct EPgen {
  F f;
  __device__ __forceinline__ void operator()(f32x4 (&acc)[4][4], int mw, int nw, int lane, int nt) const {
#pragma unroll
    for (int i = 0; i < 4; i++)
#pragma unroll
      for (int j = 0; j < 4; j++) f(mw + j * 16 + (lane & 15), nw + i * 16 + (lane >> 4) * 4, acc[i][j], nt);
  }
};

template <class AL, class EP>
__device__ __forceinline__ void gemm_jobs(const AL& al, const u16* Wt, int K, int Mt, int Nt, const EP& ep, u16* sm,
                                          int job0, int jstride) {
  for (int t = job0; t < Mt * Nt; t += jstride) {
    int mt = t % Mt, nt = t / Mt;
    gemm_tile(al, Wt, K, mt * 128, nt * 128, nt, ep, sm);
  }
}

__device__ __forceinline__ void transpose_tile(const TDesc& d, int tile, float* sm) {
  const int ktn = d.K >> 6;
  const int kt = tile % ktn, ntl = tile / ktn;
  const int k0 = kt * 64, n0 = ntl * 64;
  const int tid = ltid();
  __syncthreads();
#pragma unroll
  for (int i = 0; i < 16; i++) {
    int e = tid + i * 256;
    int kk = e >> 6, nn = e & 63;
    const int nc = n0 + nn;
    float v = __builtin_nontemporal_load(&d.src[(size_t)(k0 + kk) * d.N + (nc < d.N ? nc : d.N - 1)]);
    sm[kk * 65 + nn] = (nc < d.N) ? v : 0.f;
  }
  __syncthreads();
#pragma unroll
  for (int i = 0; i < 2; i++) {
    int e = tid + i * 256;
    int nn = e >> 3, kc = (e & 7) * 8;
    float f[8];
#pragma unroll
    for (int q = 0; q < 8; q++) f[q] = sm[(kc + q) * 65 + nn];
    *(bf16x8*)(d.dst + (size_t)(n0 + nn) * d.K + k0 + kc) = pack8(f);
  }
}
__device__ __forceinline__ void transpose_jobs(const TDesc* tab, int ntab, int ntiles, float* sm, int job0, int jstride) {
  for (int t = job0; t < ntiles; t += jstride) {
    int di = 0;
    for (int i = 1; i < ntab; i++)
      if (t >= tab[i].t0) di = i;
    transpose_tile(tab[di], t - tab[di].t0, sm);
  }
}

__device__ __forceinline__ void lru_weight_job(const P& p, int h) {
  for (int e = ltid(); e < 128 * 64; e += 256) {
    const int r = e >> 6, k = e & 63;
    const int ch = (r >> 6) * 32 + ((r >> 5) & 1) * 16 + (r & 15);
    const float* src = ((r >> 4) & 1) ? p.lw_x : p.lw_a;
    p.Lwt[(size_t)(h * 128 + r) * 64 + k] = f2bf(src[h * 4096 + k * 64 + ch]);
  }
}

__device__ __forceinline__ void norm_rows(const float* in, const float* gain, u16* outb, int nrows, int job0w, int jstridew) {
  const int lane = ltid() & 63;
  for (int r = job0w; r < nrows; r += jstridew) {
    const float4* ip = (const float4*)(in + (size_t)r * 1024);
    float4 v[4];
    float ss = 0.f;
#pragma unroll
    for (int i = 0; i < 4; i++) {
      v[i] = ip[lane + i * 64];
      ss += v[i].x * v[i].x + v[i].y * v[i].y + v[i].z * v[i].z + v[i].w * v[i].w;
    }
    ss = wave_sum(ss);
    float sc = rsqrtf(ss * (1.f / 1024.f) + 1e-6f);
#pragma unroll
    for (int i = 0; i < 4; i++) {
      float4 g = ((const float4*)gain)[lane + i * 64];
      *(uint2*)(outb + (size_t)r * 1024 + (lane + i * 64) * 4) =
          pack4(v[i].x * sc * g.x, v[i].y * sc * g.y, v[i].z * sc * g.z, v[i].w * sc * g.w);
    }
  }
}
#define RN_R 2
__device__ __forceinline__ void resid_norm(const float* hin, const u16* y, const float* gpost, const float* gpre, float* hout, u16* hn,
                           int job0w, int jstridew) {
  const int lane = ltid() & 63;
  for (int r0 = job0w * RN_R; r0 < T_TOK; r0 += jstridew * RN_R) {
    uint2 yu[RN_R][4];
    float4 h4[RN_R][4];
#pragma unroll
    for (int q = 0; q < RN_R; q++)
#pragma unroll
      for (int i = 0; i < 4; i++) {
        { typedef unsigned u32x2_ __attribute__((ext_vector_type(2)));
          const u32x2_ t_ = __builtin_nontemporal_load((const u32x2_*)(y + (size_t)(r0 + q) * 1024 + (lane + i * 64) * 4));
          yu[q][i] = make_uint2(t_[0], t_[1]); }
        {
          const f32x4 t_ = __builtin_nontemporal_load((const f32x4*)(hin + (size_t)(r0 + q) * 1024) + lane + i * 64);
          h4[q][i] = make_float4(t_[0], t_[1], t_[2], t_[3]); }
      }
    float4 gp[4];
#pragma unroll
    for (int i = 0; i < 4; i++) gp[i] = ((const float4*)gpost)[lane + i * 64];
#pragma unroll
    for (int q = 0; q < RN_R; q++) {
      const int r = r0 + q;
      float yv[16];
      float ss = 0.f;
#pragma unroll
      for (int i = 0; i < 4; i++) {
        unpack4(yu[q][i], yv + i * 4);
#pragma unroll
        for (int e = 0; e < 4; e++) ss += yv[i * 4 + e] * yv[i * 4 + e];
      }
      ss = wave_sum(ss);
      const float sc = rsqrtf(ss * (1.f / 1024.f) + 1e-6f);
      float hv[16];
      float s2 = 0.f;
#pragma unroll
      for (int i = 0; i < 4; i++) {
        hv[i * 4 + 0] = h4[q][i].x + yv[i * 4 + 0] * sc * gp[i].x;
        hv[i * 4 + 1] = h4[q][i].y + yv[i * 4 + 1] * sc * gp[i].y;
        hv[i * 4 + 2] = h4[q][i].z + yv[i * 4 + 2] * sc * gp[i].z;
        hv[i * 4 + 3] = h4[q][i].w + yv[i * 4 + 3] * sc * gp[i].w;
#pragma unroll
        for (int e = 0; e < 4; e++) s2 += hv[i * 4 + e] * hv[i * 4 + e];
        __builtin_nontemporal_store((f32x4){hv[i * 4], hv[i * 4 + 1], hv[i * 4 + 2], hv[i * 4 + 3]}, (f32x4*)(hout + (size_t)r * 1024) + lane + i * 64);
      }
      if (gpre) {
        s2 = wave_sum(s2);
        const float sc2 = rsqrtf(s2 * (1.f / 1024.f) + 1e-6f);
#pragma unroll
        for (int i = 0; i < 4; i++) {
          float4 g = ((const float4*)gpre)[lane + i * 64];
          *(uint2*)(hn + (size_t)r * 1024 + (lane + i * 64) * 4) =
              pack4(hv[i * 4] * sc2 * g.x, hv[i * 4 + 1] * sc2 * g.y, hv[i * 4 + 2] * sc2 * g.z, hv[i * 4 + 3] * sc2 * g.w);
        }
      }
    }
  }
}

__device__ __forceinline__ void s5_precompute(const P& p, int g, float* sm) {
  float* lp_re = sm;
  float* lp_im = lp_re + 17 * 64;
  float* bb_re = lp_im + 17 * 64;
  float* bb_im = bb_re + 1024;
  float* c_re = bb_im + 1024;
  float* c_im = c_re + 1024;
  float* Kt = c_im + 1024;
  const int tid = ltid();
  __syncthreads();
  const float delta = expf(p.s5_ls[g]);
  for (int e = tid; e < 17 * 64; e += 256) {
    int tau = e >> 6, n = e & 63;
    float lr = fminf(p.s5_lre[g * 64 + n], -1e-4f), li = p.s5_lim[g * 64 + n];
    float a = tau * delta * lr, b = tau * delta * li;
    float s, c;
    sincosf(b, &s, &c);
    float ea = expf(a);
    lp_re[e] = ea * c; lp_im[e] = ea * s;
  }
  for (int e = tid; e < 1024; e += 256) {
    int n = e >> 4;
    float lr = fminf(p.s5_lre[g * 64 + n], -1e-4f), li = p.s5_lim[g * 64 + n];
    float a = delta * lr, b = delta * li;
    float s, c, sh, ch;
    sincosf(b, &s, &c);
    sincosf(0.5f * b, &sh, &ch);
    float zr = expm1f(a) * c - 2.f * sh * sh, zi = expf(a) * s;
    float den = 1.f / (lr * lr + li * li);
    float fr = (zr * lr + zi * li) * den, fi = (zi * lr - zr * li) * den;
    float br = p.s5_bre[(size_t)g * 1024 + e], bi = p.s5_bim[(size_t)g * 1024 + e];
    bb_re[e] = fr * br - fi * bi; bb_im[e] = fr * bi + fi * br;
    c_re[e] = p.s5_cre[(size_t)g * 1024 + e]; c_im[e] = p.s5_cim[(size_t)g * 1024 + e];
  }
  __syncthreads();
  {
    const int c = (tid >> 4) & 15, cp = tid & 15;
    float kacc[16];
#pragma unroll
    for (int t = 0; t < 16; t++) kacc[t] = 0.f;
    for (int n = 0; n < 64; n++) {
      const float cr = c_re[c * 64 + n], ci = c_im[c * 64 + n], br = bb_re[n * 16 + cp], bi = bb_im[n * 16 + cp];
      const float Pn = cr * br - ci * bi, Qn = cr * bi + ci * br;
#pragma unroll
      for (int t = 0; t < 16; t++) kacc[t] += lp_re[t * 64 + n] * Pn - lp_im[t * 64 + n] * Qn;
    }
#pragma unroll
    for (int t = 0; t < 16; t++) Kt[t * 256 + tid] = kacc[t];
  }
  __syncthreads();
  u16* W1 = p.S5W1 + (size_t)g * 384 * 256;
  for (int e = tid; e < 384 * 32; e += 256) {
    int j = e >> 5, k0 = (e & 31) * 8;
    int s = k0 >> 4, cp0 = k0 & 15;
    float f[8];
    if (j < 256) {
      int t = j >> 4, c = j & 15;
#pragma unroll
      for (int q = 0; q < 8; q++) f[q] = (s <= t) ? Kt[((t - s) * 16 + c) * 16 + cp0 + q] : 0.f;
    } else {
      int n = (j - 256) & 63;
      bool im = (j - 256) >= 64;
      float lr = lp_re[(15 - s) * 64 + n], li = lp_im[(15 - s) * 64 + n];
#pragma unroll
      for (int q = 0; q < 8; q++) {
        float br = bb_re[n * 16 + cp0 + q], bi = bb_im[n * 16 + cp0 + q];
        f[q] = im ? (lr * bi + li * br) : (lr * br - li * bi);
      }
    }
    *(bf16x8*)(W1 + (size_t)j * 256 + k0) = pack8(f);
  }
  u16* W2 = p.S5W2 + (size_t)g * 256 * 128;
  for (int e = tid; e < 256 * 16; e += 256) {
    int j = e >> 4, k0 = (e & 15) * 8;
    int t = j >> 4, c = j & 15;
    float f[8];
#pragma unroll
    for (int q = 0; q < 8; q++) {
      int k = k0 + q;
      int n = k & 63;
      float lr = lp_re[(t + 1) * 64 + n], li = lp_im[(t + 1) * 64 + n];
      float cr = c_re[c * 64 + n], ci = c_im[c * 64 + n];
      f[q] = (k < 64) ? (cr * lr - ci * li) : -(cr * li + ci * lr);
    }
    *(bf16x8*)(W2 + (size_t)j * 128 + k0) = pack8(f);
  }
}

#define PROJ0_LD 2064
__device__ __forceinline__ void gla_cumdecay(const P& p, const u16* proj, int t0, int h, float* bl, float* dl, float* w2s) {
  const int tid = ltid();
  for (int e = tid; e < 1024; e += 256) {
    int t = e >> 4, r = e & 15;
    dl[e] = bf2f(proj[(size_t)(t0 + t) * PROJ0_LD + 1536 + r]);
    int rr = e >> 6, d = e & 63;
    w2s[e] = p.gla_w2[rr * 256 + h * 64 + d];
  }
  __syncthreads();
  const int d = tid & 63, q = tid >> 6;
  const float bd = p.gla_bd[h * 64 + d];
  float run = 0.f;
  float loc[16];
#pragma unroll
  for (int i = 0; i < 16; i++) {
    int t = q * 16 + i;
    float x = bd;
#pragma unroll
    for (int r = 0; r < 16; r++) x += dl[t * 16 + r] * w2s[r * 64 + d];
    run += logsigmoidf_(x) * (1.f / 16.f);
    loc[i] = run;
  }
  bl[(q * 16 + 15) * 64 + d] = run;
  __syncthreads();
  float pre = 0.f;
  for (int qq = 0; qq < q; qq++) pre += bl[(qq * 16 + 15) * 64 + d];
  __syncthreads();
#pragma unroll
  for (int i = 0; i < 16; i++) bl[(q * 16 + i) * 64 + d] = loc[i] + pre;
  __syncthreads();
}

#define GL_ST 72
__device__ __forceinline__ void gla_state_job(const P& p, int job, char* smc) {
  const u16* proj = (const u16*)p.H;
  float* stbuf = (float*)(p.H + (size_t)T_TOK * PROJ0_LD * 2);
  const int h = job & 3, c = (job >> 2) & 63, b = job >> 8;
  const int t0 = b * SEQL + c * 64;
  float* bl = (float*)smc;
  u16* kstT = (u16*)(smc + 16384);
  u16* VtL = kstT + 64 * GL_ST;
  float* dl = (float*)(VtL + 128 * GL_ST);
  float* w2s = dl + 1024;
  const int tid = ltid(), lane = tid & 63, wave = tid >> 6;
  __syncthreads();
  gla_cumdecay(p, proj, t0, h, bl, dl, w2s);
  {
    const int s = tid >> 2, ds = (tid & 3) * 16;
    const u16* kp = proj + (size_t)(t0 + s) * PROJ0_LD + 256 + h * 64 + ds;
    float kf[16];
    unpack8(*(const uint4*)kp, kf);
    unpack8(*(const uint4*)(kp + 8), kf + 8);
#pragma unroll
    for (int i = 0; i < 16; i++) {
      int d = ds + i;
      float v = kf[i] * __expf(bl[63 * 64 + d] - bl[s * 64 + d]);
      kstT[d * GL_ST + s] = f2bf(v);
    }
    const int vs = (tid & 3) * 32;
    const u16* vp = proj + (size_t)(t0 + s) * PROJ0_LD + 512 + h * 128 + vs;
#pragma unroll
    for (int i = 0; i < 4; i++) {
      uint4 u = *(const uint4*)(vp + i * 8);
      VtL[(vs + i * 8 + 0) * GL_ST + s] = (u16)(u.x & 0xffff); VtL[(vs + i * 8 + 1) * GL_ST + s] = (u16)(u.x >> 16);
      VtL[(vs + i * 8 + 2) * GL_ST + s] = (u16)(u.y & 0xffff); VtL[(vs + i * 8 + 3) * GL_ST + s] = (u16)(u.y >> 16);
      VtL[(vs + i * 8 + 4) * GL_ST + s] = (u16)(u.z & 0xffff); VtL[(vs + i * 8 + 5) * GL_ST + s] = (u16)(u.z >> 16);
      VtL[(vs + i * 8 + 6) * GL_ST + s] = (u16)(u.w & 0xffff); VtL[(vs + i * 8 + 7) * GL_ST + s] = (u16)(u.w >> 16);
    }
    if (tid < 64) p.gdec[((b * 4 + h) * 64 + c) * 64 + tid] = __expf(bl[63 * 64 + tid]);
  }
  __syncthreads();
  f32x4 acc[8];
#pragma unroll
  for (int i = 0; i < 8; i++) acc[i] = (f32x4){0.f, 0.f, 0.f, 0.f};
#pragma unroll
  for (int kb = 0; kb < 2; kb++) {
    bf16x8 a = *(const bf16x8*)(kstT + (wave * 16 + (lane & 15)) * GL_ST + kb * 32 + (lane >> 4) * 8);
#pragma unroll
    for (int vt = 0; vt < 8; vt++) {
      bf16x8 bb = *(const bf16x8*)(VtL + (vt * 16 + (lane & 15)) * GL_ST + kb * 32 + (lane >> 4) * 8);
      acc[vt] = MFMA16(a, bb, acc[vt]);
    }
  }
  float* sp = stbuf + ((size_t)((b * 4 + h) * 64 + c)) * 8192;
#pragma unroll
  for (int vt = 0; vt < 8; vt++) {
    int v = vt * 16 + (lane & 15), d = wave * 16 + (lane >> 4) * 4;
    *(float4*)(sp + v * 64 + d) = make_float4(acc[vt][0], acc[vt][1], acc[vt][2], acc[vt][3]);
  }
}
__device__ __forceinline__ void gla_scan_job(const P& p, int job) {
  float* stbuf = (float*)(p.H + (size_t)T_TOK * PROJ0_LD * 2);
  const int e = job * 256 + ltid();
  const int bh = e >> 13, vd = e & 8191, d = e & 63;
  float* sp = stbuf + (size_t)bh * 64 * 8192 + vd;
  const float* dp = p.gdec + bh * 64 * 64 + d;
  float s = 0.f;
  for (int c0 = 0; c0 < 64; c0 += 16) {
    float ds[16], dc[16];
#pragma unroll
    for (int i = 0; i < 16; i++) { ds[i] = sp[(size_t)(c0 + i) * 8192]; dc[i] = dp[(c0 + i) * 64]; }
#pragma unroll
    for (int i = 0; i < 16; i++) { sp[(size_t)(c0 + i) * 8192] = s; s = dc[i] * s + ds[i]; }
  }
}
__device__ __forceinline__ void gla_out_job(const P& p, int job, char* smc) {
  const u16* proj = (const u16*)p.H;
  const float* stbuf = (const float*)(p.H + (size_t)T_TOK * PROJ0_LD * 2);
  const int h = job & 3, c = (job >> 2) & 63, b = job >> 8;
  const int t0 = b * SEQL + c * 64;
  float* bl = (float*)smc;
  u16* qin = (u16*)(smc + 16384);
  u16* kin = qin + 64 * GL_ST;
  u16* VtL = kin + 64 * GL_ST;
  float* dl = (float*)(VtL + 128 * GL_ST);
  float* w2s = dl + 1024;
  const int tid = ltid(), lane = tid & 63, wave = tid >> 6;
  __syncthreads();
  gla_cumdecay(p, proj, t0, h, bl, dl, w2s);
  {
    const int s = tid >> 2, ds = (tid & 3) * 16;
    const u16* qp = proj + (size_t)(t0 + s) * PROJ0_LD + h * 64 + ds;
    const u16* kp = qp + 256;
    float qf[16], kf[16];
    unpack8(*(const uint4*)qp, qf); unpack8(*(const uint4*)(qp + 8), qf + 8);
    unpack8(*(const uint4*)kp, kf); unpack8(*(const uint4*)(kp + 8), kf + 8);
#pragma unroll
    for (int i = 0; i < 16; i++) {
      float bb = bl[s * 64 + ds + i];
      qf[i] = qf[i] * 0.125f * __expf(bb);
      kf[i] = kf[i] * __expf(-bb);
    }
    *(bf16x8*)(qin + s * GL_ST + ds) = pack8(qf);
    *(bf16x8*)(qin + s * GL_ST + ds + 8) = pack8(qf + 8);
    *(bf16x8*)(kin + s * GL_ST + ds) = pack8(kf);
    *(bf16x8*)(kin + s * GL_ST + ds + 8) = pack8(kf + 8);
    const int vs = (tid & 3) * 32;
    const u16* vp = proj + (size_t)(t0 + s) * PROJ0_LD + 512 + h * 128 + vs;
#pragma unroll
    for (int i = 0; i < 4; i++) {
      uint4 u = *(const uint4*)(vp + i * 8);
      VtL[(vs + i * 8 + 0) * GL_ST + s] = (u16)(u.x & 0xffff); VtL[(vs + i * 8 + 1) * GL_ST + s] = (u16)(u.x >> 16);
      VtL[(vs + i * 8 + 2) * GL_ST + s] = (u16)(u.y & 0xffff); VtL[(vs + i * 8 + 3) * GL_ST + s] = (u16)(u.y >> 16);
      VtL[(vs + i * 8 + 4) * GL_ST + s] = (u16)(u.z & 0xffff); VtL[(vs + i * 8 + 5) * GL_ST + s] = (u16)(u.z >> 16);
      VtL[(vs + i * 8 + 6) * GL_ST + s] = (u16)(u.w & 0xffff); VtL[(vs + i * 8 + 7) * GL_ST + s] = (u16)(u.w >> 16);
    }
  }
  __syncthreads();
  f32x4 S[4];
#pragma unroll
  for (int i = 0; i < 4; i++) S[i] = (f32x4){0.f, 0.f, 0.f, 0.f};
  bf16x8 qf0 = *(const bf16x8*)(qin + (wave * 16 + (lane & 15)) * GL_ST + (lane >> 4) * 8);
  bf16x8 qf1 = *(const bf16x8*)(qin + (wave * 16 + (lane & 15)) * GL_ST + 32 + (lane >> 4) * 8);
#pragma unroll
  for (int si = 0; si < 4; si++) {
    if (si <= wave) {
      bf16x8 k0 = *(const bf16x8*)(kin + (si * 16 + (lane & 15)) * GL_ST + (lane >> 4) * 8);
      bf16x8 k1 = *(const bf16x8*)(kin + (si * 16 + (lane & 15)) * GL_ST + 32 + (lane >> 4) * 8);
      S[si] = MFMA16(k0, qf0, S[si]);
      S[si] = MFMA16(k1, qf1, S[si]);
      if (si == wave) {
#pragma unroll
        for (int r = 0; r < 4; r++)
          if (((lane >> 4) * 4 + r) > (lane & 15)) S[si][r] = 0.f;
      }
    }
  }
  f32x4 O[8];
#pragma unroll
  for (int i = 0; i < 8; i++) O[i] = (f32x4){0.f, 0.f, 0.f, 0.f};
#pragma unroll
  for (int kb = 0; kb < 2; kb++) {
    union { bf16x8 v; unsigned u[4]; } pb;
    pb.u[0] = pack2(S[2 * kb][0], S[2 * kb][1]); pb.u[1] = pack2(S[2 * kb][2], S[2 * kb][3]);
    pb.u[2] = pack2(S[2 * kb + 1][0], S[2 * kb + 1][1]); pb.u[3] = pack2(S[2 * kb + 1][2], S[2 * kb + 1][3]);
#pragma unroll
    for (int vt = 0; vt < 8; vt++) {
      union { bf16x8 v; uint2 h[2]; } va;
      const u16* vr = VtL + (vt * 16 + (lane & 15)) * GL_ST + kb * 32 + (lane >> 4) * 4;
      va.h[0] = *(const uint2*)vr;
      va.h[1] = *(const uint2*)(vr + 16);
      O[vt] = MFMA16(va.v, pb.v, O[vt]);
    }
  }
  const float* sp = stbuf + ((size_t)((b * 4 + h) * 64 + c)) * 8192;
#pragma unroll
  for (int vt = 0; vt < 8; vt++) {
    const float* sr = sp + (vt * 16 + (lane & 15)) * 64 + (lane >> 4) * 8;
    float f[8];
    float4 a0 = *(const float4*)sr, a1 = *(const float4*)(sr + 4);
    f[0] = a0.x; f[1] = a0.y; f[2] = a0.z; f[3] = a0.w; f[4] = a1.x; f[5] = a1.y; f[6] = a1.z; f[7] = a1.w;
    O[vt] = MFMA16(pack8(f), qf0, O[vt]);
    a0 = *(const float4*)(sr + 32); a1 = *(const float4*)(sr + 36);
    f[0] = a0.x; f[1] = a0.y; f[2] = a0.z; f[3] = a0.w; f[4] = a1.x; f[5] = a1.y; f[6] = a1.z; f[7] = a1.w;
    O[vt] = MFMA16(pack8(f), qf1, O[vt]);
  }
  float ss = 0.f;
#pragma unroll
  for (int vt = 0; vt < 8; vt++)
#pragma unroll
    for (int r = 0; r < 4; r++) ss += O[vt][r] * O[vt][r];
  ss = xadd32(xadd16(ss));
  const float sc = rsqrtf(ss * (1.f / 128.f) + 1e-6f);
  const int tok = t0 + wave * 16 + (lane & 15);
#pragma unroll
  for (int vt = 0; vt < 8; vt++) {
    const int v = vt * 16 + (lane >> 4) * 4;
    float gt[4];
    unpack4(*(const uint2*)(proj + (size_t)tok * PROJ0_LD + 1024 + h * 128 + v), gt);
    float4 ng = *(const float4*)(p.gla_ng + h * 128 + v);
    float o0 = O[vt][0] * sc * ng.x * (gt[0] * sigmoidf_(gt[0]));
    float o1 = O[vt][1] * sc * ng.y * (gt[1] * sigmoidf_(gt[1]));
    float o2 = O[vt][2] * sc * ng.z * (gt[2] * sigmoidf_(gt[2]));
    float o3 = O[vt][3] * sc * ng.w * (gt[3] * sigmoidf_(gt[3]));
    *(uint2*)(p.A + (size_t)tok * 1024 + h * 128 + v) = pack4(o0, o1, o2, o3);
  }
}

__device__ __forceinline__ void s5_scan_job(const P& p, int job, float* sm) {
  const float* sloc = (const float*)p.B;
  u16* hin = p.B + (size_t)8 * 1024 * 1024;
  const int tid = ltid(), n = tid & 63, seg = tid >> 6;
  const int g = job & 31, b = job >> 5;
  const float delta = expf(p.s5_ls[g]);
  const float lr = fminf(p.s5_lre[g * 64 + n], -1e-4f), li = p.s5_lim[g * 64 + n];
  float sn, cs;
  sincosf(16.f * delta * li, &sn, &cs);
  const float ea = expf(16.f * delta * lr);
  const float mr = ea * cs, mi = ea * sn;
  float* segR = sm;
  float* segI = sm + 256;
  __syncthreads();
  const size_t base = ((size_t)((b * 256 + seg * 64) * 32 + g)) * 128 + n;
  float hr = 0.f, hi = 0.f;
  for (int c0 = 0; c0 < 64; c0 += 16) {
    float sr[16], si[16];
#pragma unroll
    for (int i = 0; i < 16; i++) { sr[i] = sloc[base + (size_t)(c0 + i) * 4096]; si[i] = sloc[base + (size_t)(c0 + i) * 4096 + 64]; }
#pragma unroll
    for (int i = 0; i < 16; i++) {
      const float nr = mr * hr - mi * hi + sr[i], ni = mr * hi + mi * hr + si[i];
      hr = nr; hi = ni;
    }
  }
  segR[seg * 64 + n] = hr; segI[seg * 64 + n] = hi;
  float pr = mr, pi = mi;
#pragma unroll
  for (int q = 0; q < 6; q++) { const float t = pr * pr - pi * pi; pi = 2.f * pr * pi; pr = t; }
  __syncthreads();
  hr = 0.f; hi = 0.f;
  for (int s2 = 0; s2 < seg; s2++) {
    const float nr = pr * hr - pi * hi + segR[s2 * 64 + n], ni = pr * hi + pi * hr + segI[s2 * 64 + n];
    hr = nr; hi = ni;
  }
  for (int c0 = 0; c0 < 64; c0 += 16) {
    float sr[16], si[16];
#pragma unroll
    for (int i = 0; i < 16; i++) { sr[i] = sloc[base + (size_t)(c0 + i) * 4096]; si[i] = sloc[base + (size_t)(c0 + i) * 4096 + 64]; }
#pragma unroll
    for (int i = 0; i < 16; i++) {
      const size_t o = base + (size_t)(c0 + i) * 4096;
      hin[o] = f2bf(hr); hin[o + 64] = f2bf(hi);
      const float nr = mr * hr - mi * hi + sr[i], ni = mr * hi + mi * hr + si[i];
      hr = nr; hi = ni;
    }
  }
}

#define AK_ST 264
#define AV_ST 40
__device__ __forceinline__ void attn_job(const P& p, int job, u16* sm) {
  const int qt = job & 63, h = (job >> 6) & 3, b = job >> 8;
  const int tid = ltid(), lane = tid & 63, wave = tid >> 6;
  const int tok = b * SEQL + qt * 64 + wave * 16 + (lane & 15);
  u16* Ks = sm;
  u16* Vs = sm + 32 * AK_ST;
  const u16* qp = p.B + (size_t)tok * 1024 + h * 256 + (lane >> 4) * 8;
  bf16x8 qf[8];
#pragma unroll
  for (int kb = 0; kb < 8; kb++) qf[kb] = *(const bf16x8*)(qp + kb * 32);
  f32x4 O[16];
#pragma unroll
  for (int i = 0; i < 16; i++) O[i] = (f32x4){0.f, 0.f, 0.f, 0.f};
  float mrun = -1e30f, lrun = 0.f;
  const int krow = tid >> 5, kch = (tid & 31) * 8;
  const int vrow = tid >> 2, vch = (tid & 3) * 8;
  const u16* kg = p.Kp + (size_t)(b * 256 + krow) * 1024 + h * 256 + kch;
  const u16* vg = p.Vt + ((size_t)((b * 4 + h) * 256 + vrow)) * 256 + vch;
  bf16x8 rk[4], rv[4];
#pragma unroll
  for (int i = 0; i < 4; i++) { rk[i] = *(const bf16x8*)(kg + (size_t)(8 * i) * 1024); rv[i] = *(const bf16x8*)(vg + (size_t)(64 * i) * 256); }
#pragma unroll 1
  for (int nb2 = 0; nb2 < 8; nb2++) {
    __syncthreads();
#pragma unroll
    for (int i = 0; i < 4; i++) {
      *(bf16x8*)(Ks + (krow + 8 * i) * AK_ST + kch) = rk[i];
      *(bf16x8*)(Vs + (vrow + 64 * i) * AV_ST + vch) = rv[i];
    }
    __syncthreads();
    if (nb2 + 1 < 8) {
#pragma unroll
      for (int i = 0; i < 4; i++) {
        rk[i] = *(const bf16x8*)(kg + (size_t)((nb2 + 1) * 32 + 8 * i) * 1024);
        rv[i] = *(const bf16x8*)(vg + (size_t)(64 * i) * 256 + (nb2 + 1) * 32);
      }
    }
    f32x4 S0 = (f32x4){0.f, 0.f, 0.f, 0.f}, S1 = (f32x4){0.f, 0.f, 0.f, 0.f};
    const u16* kr = Ks + (lane & 15) * AK_ST + (lane >> 4) * 8;
#pragma unroll
    for (int kb = 0; kb < 8; kb++) {
      const bf16x8 k0 = *(const bf16x8*)(kr + kb * 32);
      const bf16x8 k1 = *(const bf16x8*)(kr + 16 * AK_ST + kb * 32);
      S0 = MFMA16(k0, qf[kb], S0);
      S1 = MFMA16(k1, qf[kb], S1);
    }
    float mx = fmaxf(fmaxf(fmaxf(S0[0], S0[1]), fmaxf(S0[2], S0[3])), fmaxf(fmaxf(S1[0], S1[1]), fmaxf(S1[2], S1[3])));
    mx = xmax32(xmax16(mx));
    const float mnew = fmaxf(mrun, mx);
    const float alpha = __expf((mrun - mnew) * 0.0625f);
    mrun = mnew;
    float e[8];
#pragma unroll
    for (int r = 0; r < 4; r++) { e[r] = __expf((S0[r] - mnew) * 0.0625f); e[4 + r] = __expf((S1[r] - mnew) * 0.0625f); }
    float ps = (e[0] + e[1]) + (e[2] + e[3]) + (e[4] + e[5]) + (e[6] + e[7]);
    ps = xadd32(xadd16(ps));
    lrun = lrun * alpha + ps;
    const bf16x8 pf = pack8(e);
    const u16* vr = Vs + (lane & 15) * AV_ST + (lane >> 4) * 4;
#pragma unroll
    for (int dt = 0; dt < 16; dt++) {
      union { bf16x8 v; uint2 hh[2]; } va;
      va.hh[0] = *(const uint2*)(vr + dt * 16 * AV_ST);
      va.hh[1] = *(const uint2*)(vr + dt * 16 * AV_ST + 16);
      f32x4 o = O[dt];
      o[0] *= alpha; o[1] *= alpha; o[2] *= alpha; o[3] *= alpha;
      O[dt] = MFMA16(va.v, pf, o);
    }
  }
  const float inv = 1.f / lrun;
  u16* op = p.A + (size_t)tok * 1024 + h * 256 + (lane >> 4) * 4;
#pragma unroll
  for (int dt = 0; dt < 16; dt++) *(uint2*)(op + dt * 16) = pack4(O[dt][0] * inv, O[dt][1] * inv, O[dt][2] * inv, O[dt][3] * inv);
}

#define PROJ1_LD 2816
#define RW_TC 16
struct RwBuf { float dec[RW_TC][64], kk[RW_TC][64], kka[RW_TC][64], kp[RW_TC][64], wr[RW_TC][64], v[RW_TC][16], c[RW_TC][2]; };
__device__ __forceinline__ void rwkv_scan_job(const P& p, int job, char* smc) {
  const u16* proj = (const u16*)p.H;
  const u16* ldb = (const u16*)(p.H + (size_t)T_TOK * PROJ1_LD * 2);
  const u16* ab = ldb + (size_t)T_TOK * 512;
  const int rq = job & 3, h = (job >> 2) & 7, b = job >> 5;
  RwBuf* bufs = (RwBuf*)smc;
  float* ybuf = (float*)(smc + 2 * sizeof(RwBuf));
  const int tid = ltid(), lane = tid & 63, wave = tid >> 6;
  const int jg = tid & 15, tl = tid >> 4;
  const int col = h * 64 + jg * 4;
  float mur[4], muk[4], muv[4], kkc[4], kac[4], rkc[4];
#pragma unroll
  for (int i = 0; i < 4; i++) {
    mur[i] = p.mu[col + i]; muk[i] = p.mu[576 + col + i]; muv[i] = p.mu[1088 + col + i];
    kkc[i] = p.k_k[col + i]; kac[i] = p.k_a[col + i]; rkc[i] = p.r_k[col + i];
  }
  uint2 g_r, g_rp, g_k, g_kp, g_v, g_vp, g_ld, g_a;
  size_t g_t = 0;
  bool g_first = false;
  auto gload = [&](int c) {
    const int l = c * RW_TC + tl;
    const size_t t = (size_t)b * SEQL + l;
    const u16* pr = proj + t * PROJ1_LD + col;
    g_r = *(const uint2*)pr; g_k = *(const uint2*)(pr + 576); g_v = *(const uint2*)(pr + 1088);
    const u16* pp = pr - ((l > 0) ? PROJ1_LD : 0);
    g_rp = *(const uint2*)pp; g_kp = *(const uint2*)(pp + 576); g_vp = *(const uint2*)(pp + 1088);
    g_first = (l == 0);
    g_ld = *(const uint2*)(ldb + t * 512 + col);
    g_a = *(const uint2*)(ab + t * 512 + col);
    g_t = t;
  };
  auto stage = [&](RwBuf& bf) {
    float r[4], rp[4], k[4], kpv[4], v[4], vp[4], ld[4], a[4];
    unpack4(g_r, r); unpack4(g_rp, rp); unpack4(g_k, k); unpack4(g_kp, kpv); unpack4(g_v, v); unpack4(g_vp, vp);
    if (g_first) {
#pragma unroll
      for (int i = 0; i < 4; i++) { rp[i] = 0.f; kpv[i] = 0.f; vp[i] = 0.f; }
    }
    unpack4(g_ld, ld); unpack4(g_a, a);
    float kkr[4], kpr[4], rs[4], vs[4], ss = 0.f;
#pragma unroll
    for (int i = 0; i < 4; i++) {
      rs[i] = r[i] + (rp[i] - r[i]) * mur[i];
      float ks = k[i] + (kpv[i] - k[i]) * muk[i];
      vs[i] = v[i] + (vp[i] - v[i]) * muv[i];
      kkr[i] = ks * kkc[i];
      ss += kkr[i] * kkr[i];
      kpr[i] = ks * (1.f + (a[i] - 1.f) * kac[i]);
    }
    ss = sum16(ss);
    const float inv = rsqrtf(fmaxf(ss, 1e-24f));
    float c1 = 0.f, c2 = 0.f, c3 = 0.f;
    float dk[4], kk4[4], kka4[4], wr4[4];
#pragma unroll
    for (int i = 0; i < 4; i++) {
      kk4[i] = kkr[i] * inv;
      kka4[i] = kk4[i] * a[i];
      dk[i] = __expf(ld[i]);
      wr4[i] = dk[i] * rs[i];
      c1 += kka4[i] * rs[i];
      c2 += kpr[i] * rs[i];
      c3 += kpr[i] * rs[i] * rkc[i];
    }
    c1 = sum16(c1); c2 = sum16(c2); c3 = sum16(c3);
    *(float4*)&bf.dec[tl][jg * 4] = make_float4(dk[0], dk[1], dk[2], dk[3]);
    *(float4*)&bf.kk[tl][jg * 4] = make_float4(kk4[0], kk4[1], kk4[2], kk4[3]);
    *(float4*)&bf.kka[tl][jg * 4] = make_float4(kka4[0], kka4[1], kka4[2], kka4[3]);
    *(float4*)&bf.kp[tl][jg * 4] = make_float4(kpr[0], kpr[1], kpr[2], kpr[3]);
    *(float4*)&bf.wr[tl][jg * 4] = make_float4(wr4[0], wr4[1], wr4[2], wr4[3]);
    if ((jg >> 2) == rq) *(float4*)&bf.v[tl][(jg & 3) * 4] = make_float4(vs[0], vs[1], vs[2], vs[3]);
    if (jg == 0) { bf.c[tl][0] = c1; bf.c[tl][1] = c2; if (rq == 0) p.c3buf[(size_t)g_t * 8 + h] = c3; }
  };
  __syncthreads();
  gload(0);
  stage(bufs[0]);
  __syncthreads();
  typedef float v2f __attribute__((ext_vector_type(2)));
  v2f Sa = {0.f, 0.f}, Sb = {0.f, 0.f};
  const int il = wave * 4 + (lane >> 4);
  const float m0 = ((lane & 15) == 0) ? 1.f : 0.f;
  const bool b3 = lane & 8, b2 = lane & 4, b1 = lane & 2, b0 = lane & 1;
  const int NCH = SEQL / RW_TC;
  for (int c = 0; c < NCH; c++) {
    const bool more = (c + 1) < NCH;
    if (more) gload(c + 1);
    const RwBuf& bf = bufs[c & 1];
    float* yb = ybuf + (c & 1) * 256;
    float yv[RW_TC];
    float4 o_dec[3], o_kk[3], o_kka[3], o_kp[3], o_wr[3];
    float o_vi[3];
    float2 o_c[3];
#define RW_LD(slot, tt)                                                                          \
    { o_dec[slot] = *(const float4*)&bf.dec[tt][jg * 4]; o_kk[slot] = *(const float4*)&bf.kk[tt][jg * 4];   \
      o_kka[slot] = *(const float4*)&bf.kka[tt][jg * 4]; o_kp[slot] = *(const float4*)&bf.kp[tt][jg * 4];   \
      o_wr[slot] = *(const float4*)&bf.wr[tt][jg * 4]; o_vi[slot] = bf.v[tt][il]; o_c[slot] = *(const float2*)&bf.c[tt][0]; }
    RW_LD(0, 0);
    RW_LD(1, 1);
#pragma unroll
    for (int t = 0; t < RW_TC; t++) {
      if (t + 2 < RW_TC) RW_LD((t + 2) % 3, t + 2);
      const float4 dec = o_dec[t % 3], kk = o_kk[t % 3], kka = o_kka[t % 3], kp = o_kp[t % 3], wr = o_wr[t % 3];
      const float vi = o_vi[t % 3], c1 = o_c[t % 3].x, c2 = o_c[t % 3].y;
      const v2f kk0 = {kk.x, kk.y}, kk1 = {kk.z, kk.w}, wr0 = {wr.x, wr.y}, wr1 = {wr.z, wr.w};
      v2f ps = Sa * kk0 + Sb * kk1;
      v2f py = Sa * wr0 + Sb * wr1;
      float sa = ps.x + ps.y, yd = py.x + py.y;
      sa = sum16(sa);
      yv[t] = yd + m0 * (vi * c2 - sa * c1);
      const v2f dec0 = {dec.x, dec.y}, dec1 = {dec.z, dec.w}, ka0 = {kka.x, kka.y}, ka1 = {kka.z, kka.w},
                kp0 = {kp.x, kp.y}, kp1 = {kp.z, kp.w};
      const v2f sav = {sa, sa}, viv = {vi, vi};
      Sa = Sa * dec0 - sav * ka0 + viv * kp0;
      Sb = Sb * dec1 - sav * ka1 + viv * kp1;
    }
#undef RW_LD
    {
      float r8[8], r4[4], r2[2];
#pragma unroll
      for (int i = 0; i < 8; i++) {
        const float keep = b3 ? yv[i + 8] : yv[i], send = b3 ? yv[i] : yv[i + 8];
        r8[i] = keep + dppf<0x128>(send);
      }
#pragma unroll
      for (int i = 0; i < 4; i++) {
        const float keep = b2 ? r8[i + 4] : r8[i], send = b2 ? r8[i] : r8[i + 4];
        r4[i] = keep + dppf<0x141>(send);
      }
#pragma unroll
      for (int i = 0; i < 2; i++) {
        const float keep = b1 ? r4[i + 2] : r4[i], send = b1 ? r4[i] : r4[i + 2];
        r2[i] = keep + dppf<0x4E>(send);
      }
      const float keep = b0 ? r2[1] : r2[0], send = b0 ? r2[0] : r2[1];
      const float ysum = keep + dppf<0xB1>(send);
      yb[(lane & 15) * 16 + il] = ysum;
    }
    if (more) stage(bufs[(c + 1) & 1]);
    __syncthreads();
    {
      const int tt = tid >> 4, ii = tid & 15;
      const size_t t = (size_t)b * SEQL + c * RW_TC + tt;
      p.A[t * 1024 + h * 64 + rq * 16 + ii] = f2bf(yb[tt * 16 + ii]);
    }
  }
}

#define LRU_LB 16
__device__ __forceinline__ void lru_scan_job(const P& p, int job, float* sm) {
  const u16* proj = (const u16*)p.H;
  const u16* lab = p.B;
  const u16* bbuf = p.B + (size_t)T_TOK * 512;
  const int lane = ltid() & 63, seg = ltid() >> 6;
  const int b = job >> 3, ch = (job & 7) * 64 + lane;
  const size_t tb = (size_t)b * SEQL + seg * 1024;
  float* segP = sm;
  float* segH = sm + 256;
  __syncthreads();
  float P_ = 1.f, hl = 0.f;
  {
    u16 la_n[LRU_LB], b_n[LRU_LB];
#pragma unroll
    for (int i = 0; i < LRU_LB; i++) { la_n[i] = lab[(tb + i) * 512 + ch]; b_n[i] = bbuf[(tb + i) * 512 + ch]; }
    for (int l0 = 0; l0 < 1024; l0 += LRU_LB) {
      u16 la_c[LRU_LB], b_c[LRU_LB];
#pragma unroll
      for (int i = 0; i < LRU_LB; i++) { la_c[i] = la_n[i]; b_c[i] = b_n[i]; }
      if (l0 + LRU_LB < 1024) {
#pragma unroll
        for (int i = 0; i < LRU_LB; i++) { la_n[i] = lab[(tb + l0 + LRU_LB + i) * 512 + ch]; b_n[i] = bbuf[(tb + l0 + LRU_LB + i) * 512 + ch]; }
      }
#pragma unroll
      for (int i = 0; i < LRU_LB; i++) {
        const float a = __expf(bf2f(la_c[i]));
        hl = a * hl + bf2f(b_c[i]);
        P_ *= a;
      }
    }
  }
  segP[seg * 64 + lane] = P_;
  segH[seg * 64 + lane] = hl;
  __syncthreads();
  float hs = 0.f;
  for (int s2 = 0; s2 < seg; s2++) hs = segP[s2 * 64 + lane] * hs + segH[s2 * 64 + lane];
  {
    u16 la_n[LRU_LB], b_n[LRU_LB], g_n[LRU_LB];
#pragma unroll
    for (int i = 0; i < LRU_LB; i++) {
      la_n[i] = lab[(tb + i) * 512 + ch]; b_n[i] = bbuf[(tb + i) * 512 + ch]; g_n[i] = proj[(tb + i) * PROJ1_LD + 2304 + ch];
    }
    for (int l0 = 0; l0 < 1024; l0 += LRU_LB) {
      u16 la_c[LRU_LB], b_c[LRU_LB], g_c[LRU_LB];
#pragma unroll
      for (int i = 0; i < LRU_LB; i++) { la_c[i] = la_n[i]; b_c[i] = b_n[i]; g_c[i] = g_n[i]; }
      if (l0 + LRU_LB < 1024) {
#pragma unroll
        for (int i = 0; i < LRU_LB; i++) {
          const size_t t = tb + l0 + LRU_LB + i;
          la_n[i] = lab[t * 512 + ch]; b_n[i] = bbuf[t * 512 + ch]; g_n[i] = proj[t * PROJ1_LD + 2304 + ch];
        }
      }
#pragma unroll
      for (int i = 0; i < LRU_LB; i++) {
        const float a = __expf(bf2f(la_c[i]));
        hs = a * hs + bf2f(b_c[i]);
        const float g = bf2f(g_c[i]);
        const float u2 = 1.5957691216057308f * (g + 0.044715f * g * g * g);
        const float ge = g * frcp(1.f + __expf(-u2));
        p.A[(tb + l0 + i) * 1024 + 512 + ch] = f2bf(hs * ge);
      }
    }
  }
}

__device__ __forceinline__ void rw_shift8(const u16* proj, const float* mu, int m, int col, float* f) {
  const u16* pr = proj + (size_t)m * PROJ1_LD + col;
  float a[8], b[8];
  unpack8(*(const uint4*)pr, a);
  const bool hasprev = (m & (SEQL - 1)) != 0;
  unpack8(*(const uint4*)(pr - (hasprev ? PROJ1_LD : 0)), b);
  const float pz = hasprev ? 1.f : 0.f;
#pragma unroll
  for (int i = 0; i < 8; i++) b[i] *= pz;
  float4 m0 = *(const float4*)(mu + col), m1 = *(const float4*)(mu + col + 4);
  float mm[8] = {m0.x, m0.y, m0.z, m0.w, m1.x, m1.y, m1.z, m1.w};
#pragma unroll
  for (int i = 0; i < 8; i++) f[i] = a[i] + (b[i] - a[i]) * mm[i];
}
__device__ __forceinline__ void rw_shift4(const u16* proj, const float* mu, int m, int col, float* f) {
  const u16* pr = proj + (size_t)m * PROJ1_LD + col;
  float a[4], b[4];
  unpack4(*(const uint2*)pr, a);
  const bool hasprev = (m & (SEQL - 1)) != 0;
  unpack4(*(const uint2*)(pr - (hasprev ? PROJ1_LD : 0)), b);
  const float pz = hasprev ? 1.f : 0.f;
  b[0] *= pz; b[1] *= pz; b[2] *= pz; b[3] *= pz;
  float4 m0 = *(const float4*)(mu + col);
  f[0] = a[0] + (b[0] - a[0]) * m0.x; f[1] = a[1] + (b[1] - a[1]) * m0.y;
  f[2] = a[2] + (b[2] - a[2]) * m0.z; f[3] = a[3] + (b[3] - a[3]) * m0.w;
}

struct AL5 {
  const u16* pj; int g;
  __device__ __forceinline__ bf16x8 operator()(int m, int k, int) const {
    return *(const bf16x8*)(pj + (size_t)(m * 16 + (k >> 4)) * PROJ0_LD + 1552 + g * 16 + (k & 15));
  }
};
struct ALw { const u16* pj; const float* mu;
  __device__ __forceinline__ bf16x8 operator()(int m, int k, int) const {
    float f[8]; rw_shift8(pj, mu, m, 512 + k, f);
#pragma unroll
    for (int i = 0; i < 8; i++) f[i] = fast_tanh(f[i]);
    return pack8(f); } };
struct ALa { const u16* pj; const float* mu;
  __device__ __forceinline__ bf16x8 operator()(int m, int k, int) const {
    float f[8]; rw_shift8(pj, mu, m, 1600 + k, f); return pack8(f); } };
struct ALg { const u16* pj; const float* mu;
  __device__ __forceinline__ bf16x8 operator()(int m, int k, int) const {
    float f[8]; rw_shift8(pj, mu, m, 1664 + k, f);
#pragma unroll
    for (int i = 0; i < 8; i++) f[i] = sigmoidf_(f[i]);
    return pack8(f); } };
struct ALl { const u16* pj; const float* cw; const float* cb;
  __device__ __forceinline__ bf16x8 operator()(int m, int k, int nt) const {
    const int ch = nt * 64 + k;
    float acc[8];
    float4 b0 = *(const float4*)(cb + ch), b1 = *(const float4*)(cb + ch + 4);
    acc[0] = b0.x; acc[1] = b0.y; acc[2] = b0.z; acc[3] = b0.w; acc[4] = b1.x; acc[5] = b1.y; acc[6] = b1.z; acc[7] = b1.w;
    const int l = m & (SEQL - 1);
#pragma unroll
    for (int j = 0; j < 4; j++) {
      {
        const bool ok = (l - 3 + j) >= 0;
        const float z = ok ? 1.f : 0.f;
        float x[8];
        unpack8(*(const uint4*)(pj + (size_t)(m - (ok ? 3 - j : 0)) * PROJ1_LD + 1792 + ch), x);
        float4 w0 = *(const float4*)(cw + j * 512 + ch), w1 = *(const float4*)(cw + j * 512 + ch + 4);
        acc[0] += z * w0.x * x[0]; acc[1] += z * w0.y * x[1]; acc[2] += z * w0.z * x[2]; acc[3] += z * w0.w * x[3];
        acc[4] += z * w1.x * x[4]; acc[5] += z * w1.y * x[5]; acc[6] += z * w1.z * x[6]; acc[7] += z * w1.w * x[7];
      }
    }
    return pack8(acc); } };
struct EPlru {
  const u16* pj; u16* lab; u16* bb; const float* cw; const float* cb; const float* lb_a; const float* lb_x; const float* llam;
  __device__ __forceinline__ void operator()(f32x4 (&acc)[4][4], int mw, int nw, int lane, int nt) const {
    const int wn = (nw >> 6) & 1;
    uint2 xr[2][4][4];
#pragma unroll
    for (int q = 0; q < 2; q++) {
      const int ch = nt * 64 + wn * 32 + q * 16 + (lane >> 4) * 4;
#pragma unroll
      for (int j = 0; j < 4; j++) {
        const int m = mw + j * 16 + (lane & 15);
        const int l = m & (SEQL - 1);
#pragma unroll
        for (int d = 0; d < 4; d++)
          xr[q][j][d] = *(const uint2*)(pj + (size_t)(m - (l >= d ? d : 0)) * PROJ1_LD + 1792 + ch);
      }
    }
#pragma unroll
    for (int q = 0; q < 2; q++) {
      const int ch = nt * 64 + wn * 32 + q * 16 + (lane >> 4) * 4;
      const float4 ba = *(const float4*)(lb_a + ch), bx = *(const float4*)(lb_x + ch), lm = *(const float4*)(llam + ch);
      const float4 cbv = *(const float4*)(cb + ch);
      const float4 w0 = *(const float4*)(cw + ch), w1 = *(const float4*)(cw + 512 + ch), w2 = *(const float4*)(cw + 1024 + ch),
                   w3 = *(const float4*)(cw + 1536 + ch);
      const float sp[4] = {softplusf_(-lm.x), softplusf_(-lm.y), softplusf_(-lm.z), softplusf_(-lm.w)};
      const float bav[4] = {ba.x, ba.y, ba.z, ba.w}, bxv[4] = {bx.x, bx.y, bx.z, bx.w};
      const float wd[4][4] = {{w3.x, w3.y, w3.z, w3.w}, {w2.x, w2.y, w2.z, w2.w}, {w1.x, w1.y, w1.z, w1.w}, {w0.x, w0.y, w0.z, w0.w}};
#pragma unroll
      for (int j = 0; j < 4; j++) {
        const int m = mw + j * 16 + (lane & 15);
        const int l = m & (SEQL - 1);
        float xc[4] = {cbv.x, cbv.y, cbv.z, cbv.w};
#pragma unroll
        for (int d = 0; d < 4; d++) {
          float x[4];
          unpack4(xr[q][j][d], x);
          const float z = (l >= d) ? 1.f : 0.f;
          xc[0] += z * wd[d][0] * x[0]; xc[1] += z * wd[d][1] * x[1]; xc[2] += z * wd[d][2] * x[2]; xc[3] += z * wd[d][3] * x[3];
        }
        float la[4], bo[4];
#pragma unroll
        for (int r = 0; r < 4; r++) {
          const float rg = sigmoidf_(acc[2 * q][j][r] + bav[r]);
          const float ig = sigmoidf_(acc[2 * q + 1][j][r] + bxv[r]);
          la[r] = -8.f * rg * sp[r];
          const float mult = __builtin_amdgcn_sqrtf(fmaxf(1.f - __expf(2.f * la[r]), 0.f));
          bo[r] = mult * ig * xc[r];
        }
        *(uint2*)(lab + (size_t)m * 512 + ch) = pack4(la[0], la[1], la[2], la[3]);
        *(uint2*)(bb + (size_t)m * 512 + ch) = pack4(bo[0], bo[1], bo[2], bo[3]);
      }
    }
  }
};
struct EPfin {
  const u16* pj; const float* mu; u16* A; const float* c3buf; const float* ln_g; const float* ln_b;
  __device__ __forceinline__ void operator()(f32x4 (&acc)[4][4], int mw, int nw, int lane, int) const {
    const int hh = nw >> 6;
#pragma unroll
    for (int j = 0; j < 4; j++) {
      const int m = mw + j * 16 + (lane & 15);
      float y[16], sum = 0.f;
      const float c3 = c3buf[(size_t)m * 8 + hh];
#pragma unroll
      for (int i = 0; i < 4; i++) {
        const int ch = nw + i * 16 + (lane >> 4) * 4;
        unpack4(*(const uint2*)(A + (size_t)m * 1024 + ch), y + i * 4);
        sum += y[i * 4] + y[i * 4 + 1] + y[i * 4 + 2] + y[i * 4 + 3];
      }
      sum = xadd32(xadd16(sum));
      const float mean = sum * (1.f / 64.f);
      float var = 0.f;
#pragma unroll
      for (int i = 0; i < 16; i++) var += (y[i] - mean) * (y[i] - mean);
      var = xadd32(xadd16(var));
      const float rstd = rsqrtf(var * (1.f / 64.f) + 64e-5f);
#pragma unroll
      for (int i = 0; i < 4; i++) {
        const int ch = nw + i * 16 + (lane >> 4) * 4;
        float vs[4];
        rw_shift4(pj, mu, m, 1088 + ch, vs);
        float4 lg = *(const float4*)(ln_g + ch), lb = *(const float4*)(ln_b + ch);
        float o0 = ((y[i * 4 + 0] - mean) * rstd * lg.x + lb.x + c3 * vs[0]) * acc[i][j][0];
        float o1 = ((y[i * 4 + 1] - mean) * rstd * lg.y + lb.y + c3 * vs[1]) * acc[i][j][1];
        float o2 = ((y[i * 4 + 2] - mean) * rstd * lg.z + lb.z + c3 * vs[2]) * acc[i][j][2];
        float o3 = ((y[i * 4 + 3] - mean) * rstd * lg.w + lb.w + c3 * vs[3]) * acc[i][j][3];
        *(uint2*)(A + (size_t)m * 1024 + ch) = pack4(o0, o1, o2, o3);
      }
    }
  }
};

#define XB_TMO      128
#define XB_XCNT(j)  (256  + 64 * (j))
#define XB_XSUB(j)  (1280 + 64 * (j))
#define XB_XGEN(j)  (2304 + 64 * (j))
#define XB_TOP      3328
#define XB_TOPGEN   3392
#define XCD_BAR_WORDS 3456
#define XB_SPIN_CAP (1u << 22)
#define LAS __attribute__((address_space(3)))
__device__ __forceinline__ unsigned xb_ld(unsigned* p)              { return __hip_atomic_load(p, __ATOMIC_RELAXED, __HIP_MEMORY_SCOPE_AGENT); }
__device__ __forceinline__ unsigned xb_add(unsigned* p, unsigned v) { return __hip_atomic_fetch_add(p, v, __ATOMIC_RELAXED, __HIP_MEMORY_SCOPE_AGENT); }
__device__ __forceinline__ unsigned xb_xcc_id() { return (unsigned)__builtin_amdgcn_s_getreg((3 << 11) | 20) & 0xFu; }
#define XB_SPIN(cond, bar) do { unsigned _sp = 0; while (cond) { __builtin_amdgcn_s_sleep(1); \
    if ((++_sp & 255u) == 0u) { if (xb_ld(&(bar)[XB_TMO])) break; if (_sp > XB_SPIN_CAP) { atomicAdd(&(bar)[XB_TMO], 1u); break; } } } } while (0)
struct XcdBarrier { unsigned* bar; unsigned x; volatile LAS unsigned* st; };
__device__ __forceinline__ XcdBarrier xcd_barrier_post(unsigned* bar, volatile LAS unsigned* st) {
  XcdBarrier b; b.bar = bar; b.x = xb_xcc_id(); b.st = st;
  if (threadIdx.x == 0) (void)xb_add(&bar[XB_XCNT(b.x)], 1u);
  return b;
}
__device__ __forceinline__ void xcd_barrier_complete(unsigned* bar, unsigned x, unsigned& nloc, unsigned& nx) {
  const unsigned G = gridDim.x * gridDim.y * gridDim.z;
  unsigned sum, cnt, mine, sp = 0u;
  for (;;) {
    sum = 0u; cnt = 0u; mine = 0u;
#pragma unroll
    for (unsigned j = 0; j < 16; ++j) { const unsigned c = xb_ld(&bar[XB_XCNT(j)]); sum += c; cnt += (c > 0u) ? 1u : 0u; mine = (j == x) ? c : mine; }
    if (sum == G) break;
    __builtin_amdgcn_s_sleep(1);
    if ((++sp & 255u) == 0u) { if (xb_ld(&bar[XB_TMO])) break; if (sp > XB_SPIN_CAP) { atomicAdd(&bar[XB_TMO], 1u); break; } }
  }
  nloc = mine > 0u ? mine : 1u; nx = cnt > 0u ? cnt : 1u;
}
__device__ __forceinline__ void xcd_barrier(const XcdBarrier& b) {
  asm volatile("s_waitcnt vmcnt(0)" ::: "memory");
  __syncthreads();
  if (threadIdx.x == 0) {
    unsigned* bar = b.bar;
    __builtin_amdgcn_s_waitcnt(0);
    unsigned nloc = b.st[0], nx = b.st[1];
    if (nloc == 0u) { xcd_barrier_complete(bar, b.x, nloc, nx); b.st[0] = nloc; b.st[1] = nx; }
    const unsigned old = xb_add(&bar[XB_XSUB(b.x)], 1u);
    const unsigned gen = old / nloc;
    if (old + 1u == (gen + 1u) * nloc) {
      __builtin_amdgcn_fence(__ATOMIC_RELEASE, "agent");
      asm volatile("s_waitcnt vmcnt(0)" ::: "memory");
      const unsigned og = xb_add(&bar[XB_TOP], 1u);
      const unsigned tg = og / nx;
      if (og + 1u == (tg + 1u) * nx) xb_add(&bar[XB_TOPGEN], 1u);
      else XB_SPIN(xb_ld(&bar[XB_TOPGEN]) == tg, bar);
      __builtin_amdgcn_fence(__ATOMIC_ACQUIRE, "agent");
      xb_add(&bar[XB_XGEN(b.x)], 1u);
      asm volatile("s_waitcnt vmcnt(0)" ::: "memory");
    } else {
      XB_SPIN(xb_ld(&bar[XB_XGEN(b.x)]) == gen, bar);
      __builtin_amdgcn_fence(__ATOMIC_ACQUIRE, "agent");
      asm volatile("s_waitcnt vmcnt(0)" ::: "memory");
    }
  }
  __syncthreads();
}

__device__ __forceinline__ void kv_tile(const P& p, int t, u16* smu) {
  auto fk = [=] __device__(int m, int n, const f32x4& a, int) {
    *(uint2*)(p.Kp + (size_t)m * 1024 + n) = pack4(a[0], a[1], a[2], a[3]);
  };
  auto fv = [=] __device__(int m, int n, const f32x4& a, int) {
    const int bb = m >> 8, mm = m & 255, hh = n >> 8, d = n & 255;
    u16* vp = p.Vt + ((size_t)((bb * 4 + hh) * 256 + d)) * 256 + mm;
    vp[0] = f2bf(a[0]); vp[256] = f2bf(a[1]); vp[512] = f2bf(a[2]); vp[768] = f2bf(a[3]);
  };
  if (t < 64) gemm_tile(ALbf{p.memn, 1024}, p.Wk, 1024, (t & 7) * 128, (t >> 3) * 128, 0, EPgen<decltype(fk)>{fk}, smu);
  else gemm_tile(ALbf{p.memn, 1024}, p.Wv, 1024, (t & 7) * 128, ((t - 64) >> 3) * 128, 0, EPgen<decltype(fv)>{fv}, smu);
}

__global__ void __launch_bounds__(NTHR, 2) mega(P p, int ph_lo, int ph_hi) {
  cg::grid_group grid = cg::this_grid();
  __shared__ __attribute__((aligned(1024))) char smem[73728];
  __shared__ uint4 xb_words;
  if (threadIdx.x == 0) xb_words = make_uint4(0u, 0u, 0u, 0u);
  __syncthreads();
  XcdBarrier xb; xb.bar = p.bar; xb.x = 0; xb.st = (volatile LAS unsigned*)&xb_words;
  if (blockIdx.x == 0) { for (int i = threadIdx.x; i < XCD_BAR_WORDS; i += NTHR) p.bar[i] = 0u; }
  const int nb = gridDim.x, nw = nb * 4;
  u16* smu = (u16*)smem;
  const u16* proj = (const u16*)p.H;

  for (int si = ph_lo; si < ph_hi; ++si) {
    const int ph = p.seq[si];
    if (si > ph_lo) { if (si == ph_lo + 1) { grid.sync(); xb = xcd_barrier_post(p.bar, (volatile LAS unsigned*)&xb_words); } else xcd_barrier(xb); }
    int bid = blockIdx.x;
    asm volatile("" : "+s"(bid));
    const int tid = ltid();
    const int gw = bid * 4 + (tid >> 6);
    const int layer = ph >= 15 ? 1 : 0;
    const float* ng = p.norm_gain + layer * 7 * 1024;
    switch (ph) {
      case 0: {
        if (bid < 32) s5_precompute(p, bid, (float*)smem);
        else if (bid < 40) lru_weight_job(p, bid - 32);
        if (bid >= 32) transpose_jobs(p.tab0, p.ntab0, p.ntiles0, (float*)smem, bid - 32, nb - 32);
        norm_rows(p.mem, p.norm_gain + 6 * 1024, p.memn, 1024, gw, nw);
        norm_rows(p.x, p.norm_gain, p.A, T_TOK, gw, nw);
      } break;
      case 1: {
        auto f = [=] __device__(int m, int n, const f32x4& a, int) {
          if (n < 2064) *(uint2*)((u16*)p.H + (size_t)m * PROJ0_LD + n) = pack4(a[0], a[1], a[2], a[3]);
        };
        auto f8 = [=] __device__(int m, int n, const f32x4& a, const f32x4& b) {
          *(uint4*)((u16*)p.H + (size_t)m * PROJ0_LD + n) = pack8v(a, b);
        };
        gemm_big_jobs(ALbf{p.A, 1024}, p.Win0, 1024, 16, f8, smu, bid, nb);
        __syncthreads();
        for (int t = bid; t < 128; t += nb) gemm_tile(ALbf{p.A, 1024}, p.Win0, 1024, t * 128, 16 * 128, 16, EPgen<decltype(f)>{f}, smu);
      } break;
      case 2: {
        for (int j = bid; j < 1024; j += nb) gla_state_job(p, j, smem);
        __syncthreads();
        float* ybuf = (float*)(p.H + (size_t)T_TOK * PROJ0_LD * 2 + (size_t)32 * 1024 * 1024);
        float* sloc = (float*)p.B;
        for (int t = bid; t < 32 * 8 * 3; t += nb) {
          const int g = t / 24, r = t % 24, mt = r & 7, ntl = r >> 3;
          auto f = [=] __device__(int m, int n, const f32x4& a, int) {
            if (n < 256) *(float4*)(ybuf + (size_t)(m * 16 + (n >> 4)) * 512 + g * 16 + (n & 15)) = make_float4(a[0], a[1], a[2], a[3]);
            else *(float4*)(sloc + ((size_t)(m * 32 + g)) * 128 + (n - 256)) = make_float4(a[0], a[1], a[2], a[3]);
          };
          gemm_tile(AL5{proj, g}, p.S5W1 + (size_t)g * 384 * 256, 256, mt * 128, ntl * 128, ntl, EPgen<decltype(f)>{f}, smu);
        }
      } break;
      case 3: {
        for (int j = bid; j < 512; j += nb) gla_scan_job(p, j);
        for (int t = bid; t < 256; t += nb) {
          __syncthreads();
          if (t < 128) s5_scan_job(p, t, (float*)smem); else kv_tile(p, t - 128, smu);
        }
      } break;
      case 4: {
        for (int j = bid; j < 1024; j += nb) gla_out_job(p, j, smem);
        __syncthreads();
        float* ybuf = (float*)(p.H + (size_t)T_TOK * PROJ0_LD * 2 + (size_t)32 * 1024 * 1024);
        const u16* hin = p.B + (size_t)8 * 1024 * 1024;
        for (int t = bid; t < 32 * 8 * 2; t += nb) {
          const int g = t >> 4, r = t & 15, mt = r & 7, ntl = r >> 3;
          auto f = [=] __device__(int m, int n, const f32x4& a, int) {
            const int tok = m * 16 + (n >> 4), ch = g * 16 + (n & 15);
            float* yp = ybuf + (size_t)tok * 512 + ch;
            float4 y0 = *(const float4*)yp;
            float u[4];
            unpack4(*(const uint2*)(proj + (size_t)tok * PROJ0_LD + 1552 + ch), u);
            float4 d = *(const float4*)(p.s5_d + ch);
            *(float4*)yp = make_float4(y0.x + a[0] + d.x * u[0], y0.y + a[1] + d.y * u[1], y0.z + a[2] + d.z * u[2], y0.w + a[3] + d.w * u[3]);
          };
          gemm_tile(ALbf{hin + (size_t)g * 128, 32 * 128}, p.S5W2 + (size_t)g * 256 * 128, 128, mt * 128, ntl * 128, ntl,
                    EPgen<decltype(f)>{f}, smu);
        }
      } break;
      case 5: {
        const float* ybuf = (const float*)(p.H + (size_t)T_TOK * PROJ0_LD * 2 + (size_t)32 * 1024 * 1024);
        auto f = [=] __device__(int m, int n, const f32x4& a, int) {
          float4 y = *(const float4*)(ybuf + (size_t)m * 512 + n);
          float4 bg = *(const float4*)(p.s5_bglu + n);
          *(uint2*)(p.A + (size_t)m * 1024 + 512 + n) =
              pack4(gelu_tanh(y.x) * sigmoidf_(a[0] + bg.x), gelu_tanh(y.y) * sigmoidf_(a[1] + bg.y),
                    gelu_tanh(y.z) * sigmoidf_(a[2] + bg.z), gelu_tanh(y.w) * sigmoidf_(a[3] + bg.w));
        };
        gemm_jobs(ALf32{ybuf, 512}, p.Wglu, 512, 128, 4, EPgen<decltype(f)>{f}, smu, bid, nb);
      } break;
      case 6: case 19: {
        auto f = [=] __device__(int m, int n, const f32x4& a, int) {
          *(uint2*)(p.B + (size_t)m * 1024 + n) = pack4(a[0], a[1], a[2], a[3]);
        };
        auto f8 = [=] __device__(int m, int n, const f32x4& a, const f32x4& b) { *(uint4*)(p.B + (size_t)m * 1024 + n) = pack8v(a, b); };
        gemm_big_jobs(ALbf{p.A, 1024}, ph == 6 ? p.Wout0 : p.Wout1, 1024, 8, f8, smu, bid, nb);
      } break;
      case 7: case 20:
        if (ph == 20 && bid < 128) kv_tile(p, bid, smu);
        resid_norm(ph == 7 ? p.x : p.out, p.B, ng + 1 * 1024, ng + 2 * 1024, p.out, p.A, gw, nw);
        break;
      case 8: case 21: {
        auto f = [=] __device__(int m, int n, const f32x4& a, int) {
          *(uint2*)(p.B + (size_t)m * 1024 + n) = pack4(a[0], a[1], a[2], a[3]);
        };
        auto f8 = [=] __device__(int m, int n, const f32x4& a, const f32x4& b) { *(uint4*)(p.B + (size_t)m * 1024 + n) = pack8v(a, b); };
        gemm_big_jobs(ALbf{p.A, 1024}, p.Wq, 1024, 8, f8, smu, bid, nb);
      } break;
      case 9: case 22:
        for (int j = bid; j < 1024; j += nb) attn_job(p, j, smu);
        break;
      case 10: case 23: {
        auto f = [=] __device__(int m, int n, const f32x4& a, int) {
          *(uint2*)(p.B + (size_t)m * 1024 + n) = pack4(a[0], a[1], a[2], a[3]);
        };
        auto f8 = [=] __device__(int m, int n, const f32x4& a, const f32x4& b) { *(uint4*)(p.B + (size_t)m * 1024 + n) = pack8v(a, b); };
        gemm_big_jobs(ALbf{p.A, 1024}, p.Wo, 1024, 8, f8, smu, bid, nb);
      } break;
      case 11: case 24:
        resid_norm(p.out, p.B, ng + 3 * 1024, ng + 4 * 1024, p.out, p.A, gw, nw);
        break;
      case 12: case 25: {
        u16* hid = (u16*)p.H;
        auto f = [=] __device__(int m, int n, const f32x4& a, int) {
          float r0 = fmaxf(a[0], 0.f), r1 = fmaxf(a[1], 0.f), r2 = fmaxf(a[2], 0.f), r3 = fmaxf(a[3], 0.f);
          *(uint2*)(hid + (size_t)m * 4096 + n) = pack4(r0 * r0, r1 * r1, r2 * r2, r3 * r3);
        };
        auto f8 = [=] __device__(int m, int n, const f32x4& a, const f32x4& b) {
          f32x4 ra, rb;
#pragma unroll
          for (int q = 0; q < 4; q++) { float x = fmaxf(a[q], 0.f), y = fmaxf(b[q], 0.f); ra[q] = x * x; rb[q] = y * y; }
          *(uint4*)(hid + (size_t)m * 4096 + n) = pack8v(ra, rb);
        };
        gemm_big_jobs(ALbf{p.A, 1024}, p.W1, 1024, 32, f8, smu, bid, nb);
      } break;
      case 13: case 26: {
        auto f = [=] __device__(int m, int n, const f32x4& a, int) {
          *(uint2*)(p.B + (size_t)m * 1024 + n) = pack4(a[0], a[1], a[2], a[3]);
        };
        auto f8 = [=] __device__(int m, int n, const f32x4& a, const f32x4& b) { *(uint4*)(p.B + (size_t)m * 1024 + n) = pack8v(a, b); };
        gemm_big_jobs(ALbf{(const u16*)p.H, 4096}, p.W2, 4096, 8, f8, smu, bid, nb);
      } break;
      case 14:
        resid_norm(p.out, p.B, ng + 5 * 1024, p.norm_gain + 7 * 1024, p.out, p.A, gw, nw);
        break;
      case 27:
        resid_norm(p.out, p.B, ng + 5 * 1024, nullptr, p.out, nullptr, gw, nw);
        break;
      case 15: {
        norm_rows(p.mem, p.norm_gain + 13 * 1024, p.memn, 1024, gw, nw);
        auto f = [=] __device__(int m, int n, const f32x4& a, int) {
          *(uint2*)((u16*)p.H + (size_t)m * PROJ1_LD + n) = pack4(a[0], a[1], a[2], a[3]);
        };
        auto f8 = [=] __device__(int m, int n, const f32x4& a, const f32x4& b) { *(uint4*)((u16*)p.H + (size_t)m * PROJ1_LD + n) = pack8v(a, b); };
        gemm_big_jobs(ALbf{p.A, 1024}, p.Win1, 1024, 22, f8, smu, bid, nb);
      } break;
      case 16: {
        u16* ldb = (u16*)(p.H + (size_t)T_TOK * PROJ1_LD * 2);
        u16* ab = ldb + (size_t)T_TOK * 512;
        u16* lab = p.B;
        u16* ib = p.B + (size_t)T_TOK * 512;
        auto fw = [=] __device__(int m, int n, const f32x4& a, int) {
          float4 w0 = *(const float4*)(p.w0 + n);
          float o[4] = {w0.x + a[0], w0.y + a[1], w0.z + a[2], w0.w + a[3]};
#pragma unroll
          for (int i = 0; i < 4; i++) { float wv = -softplusf_(-o[i]) - 0.5f; o[i] = -__expf(wv); }
          *(uint2*)(ldb + (size_t)m * 512 + n) = pack4(o[0], o[1], o[2], o[3]);
        };
        auto fa = [=] __device__(int m, int n, const f32x4& a, int) {
          float4 a0 = *(const float4*)(p.a0 + n);
          *(uint2*)(ab + (size_t)m * 512 + n) = pack4(sigmoidf_(a0.x + a[0]), sigmoidf_(a0.y + a[1]), sigmoidf_(a0.z + a[2]), sigmoidf_(a0.w + a[3]));
        };
        for (int t = bid; t < 512 + 512 + 1024; t += nb) {
          if (t < 512) gemm_tile(ALw{proj, p.mu}, p.Rw2t, 64, (t & 127) * 128, (t >> 7) * 128, 0, EPgen<decltype(fw)>{fw}, smu);
          else if (t < 1024) { int tt = t - 512; gemm_tile(ALa{proj, p.mu}, p.Ra2t, 64, (tt & 127) * 128, (tt >> 7) * 128, 0, EPgen<decltype(fa)>{fa}, smu); }
          else { int tt = t - 1024; gemm_tile(ALl{proj, p.conv_w, p.conv_b}, p.Lwt, 64, (tt & 127) * 128, (tt >> 7) * 128, tt >> 7, EPlru{proj, lab, ib, p.conv_w, p.conv_b, p.lb_a, p.lb_x, p.llam}, smu); }
        }
      } break;
      case 17: {
        if (bid < 128) rwkv_scan_job(p, bid, smem);
        else if (bid < 160) lru_scan_job(p, bid - 128, (float*)smem);
        else transpose_jobs(p.tab1, p.ntab1, p.ntiles1, (float*)smem, bid - 160, nb - 160);
      } break;
      case 18: {
        gemm_jobs(ALg{proj, p.mu}, p.Rg2t, 128, 128, 4, EPfin{proj, p.mu, p.A, p.c3buf, p.ln_g, p.ln_b}, smu, bid, nb);
      } break;
      default: break;
    }
  }
}

static inline size_t al256(size_t x) { return (x + 255) & ~(size_t)255; }

extern "C" void kernel_launch(void* const* d_in, const int* in_sizes, int n_in, void* d_out, int out_size,
                              void* d_ws, size_t ws_size, hipStream_t stream) {
  static int grid_blocks = 0;
  if (!grid_blocks) {
    int dev = 0, cus = 0, per_cu = 0;
    hipGetDevice(&dev);
    hipDeviceGetAttribute(&cus, hipDeviceAttributeMultiprocessorCount, dev);
    hipOccupancyMaxActiveBlocksPerMultiprocessor(&per_cu, mega, NTHR, 0);
    if (per_cu > 2) per_cu = 2;
    if (per_cu < 1) per_cu = 1;
    grid_blocks = cus * per_cu;
  }
  P p;
  memset(&p, 0, sizeof(p));
  const float** fin = (const float**)d_in;
  p.x = fin[0]; p.mem = fin[1]; p.norm_gain = fin[2]; p.wq = fin[3]; p.wk = fin[4]; p.wv = fin[5]; p.wo = fin[6];
  p.w1 = fin[7]; p.w2 = fin[8]; p.ab_w_in = fin[9]; p.gla_w2 = fin[10]; p.gla_bd = fin[11]; p.gla_ng = fin[12];
  p.s5_lre = fin[13]; p.s5_lim = fin[14]; p.s5_ls = fin[15]; p.s5_bre = fin[16]; p.s5_bim = fin[17]; p.s5_cre = fin[18];
  p.s5_cim = fin[19]; p.s5_d = fin[20]; p.s5_wglu = fin[21]; p.s5_bglu = fin[22]; p.ab_w_out = fin[23];
  p.cd_w_in = fin[24]; p.mu = fin[25]; p.w0 = fin[26]; p.rw2 = fin[27]; p.a0 = fin[28]; p.ra2 = fin[29]; p.rg2 = fin[30];
  p.k_k = fin[31]; p.k_a = fin[32]; p.r_k = fin[33]; p.ln_g = fin[34]; p.ln_b = fin[35]; p.conv_w = fin[36];
  p.conv_b = fin[37]; p.lw_a = fin[38]; p.lb_a = fin[39]; p.lw_x = fin[40]; p.lb_x = fin[41]; p.llam = fin[42];
  p.cd_w_out = fin[43];
  p.out = (float*)d_out;
  char* w = (char*)d_ws;
  size_t off = 0;
  auto alloc = [&](size_t bytes) { char* r = w + off; off = al256(off + bytes); return r; };
  const size_t MB = 1024 * 1024;
  p.Wq = (u16*)alloc(2 * MB); p.Wk = (u16*)alloc(2 * MB); p.Wv = (u16*)alloc(2 * MB); p.Wo = (u16*)alloc(2 * MB);
  p.W1 = (u16*)alloc(8 * MB); p.W2 = (u16*)alloc(8 * MB);
  p.Win0 = (u16*)alloc((size_t)2176 * 1024 * 2); p.Wout0 = (u16*)alloc(2 * MB); p.Wglu = (u16*)alloc(512 * 512 * 2);
  p.S5W1 = (u16*)alloc((size_t)32 * 384 * 256 * 2); p.S5W2 = (u16*)alloc((size_t)32 * 256 * 128 * 2);
  p.Win1 = (u16*)alloc((size_t)2816 * 1024 * 2); p.Wout1 = (u16*)alloc(2 * MB);
  p.Rw2t = (u16*)alloc(512 * 64 * 2); p.Ra2t = (u16*)alloc(512 * 64 * 2); p.Rg2t = (u16*)alloc(512 * 128 * 2);
  p.Lwt = (u16*)alloc(8 * 128 * 64 * 2);
  p.memn = (u16*)alloc(2 * MB); p.Kp = (u16*)alloc(2 * MB); p.Vt = (u16*)alloc(2 * MB);
  p.gdec = (float*)alloc(16 * 64 * 64 * 4);
  p.c3buf = (float*)alloc((size_t)T_TOK * 8 * 4);
  p.bar = (unsigned*)alloc(XCD_BAR_WORDS * 4);
  p.A = (u16*)alloc(32 * MB); p.B = (u16*)alloc(32 * MB);
  p.H = alloc((size_t)T_TOK * PROJ0_LD * 2 + 64 * MB);
  if (off > ws_size) { fprintf(stderr, "workspace too small: need %zu have %zu\n", off, ws_size); }
  int nt = 0, tiles = 0;
  auto add = [&](TDesc* tab, const float* src, u16* dst, int K, int N, int Npad) {
    tab[nt].src = src; tab[nt].dst = dst; tab[nt].K = K; tab[nt].N = N; tab[nt].Npad = Npad; tab[nt].t0 = tiles;
    tiles += (K / 64) * (Npad / 64); nt++;
  };
  add(p.tab0, p.ab_w_in, p.Win0, 1024, 2064, 2176);
  add(p.tab0, p.w1, p.W1, 1024, 4096, 4096);
  add(p.tab0, p.w2, p.W2, 4096, 1024, 1024);
  add(p.tab0, p.wq, p.Wq, 1024, 1024, 1024);
  add(p.tab0, p.wk, p.Wk, 1024, 1024, 1024);
  add(p.tab0, p.wv, p.Wv, 1024, 1024, 1024);
  add(p.tab0, p.wo, p.Wo, 1024, 1024, 1024);
  add(p.tab0, p.ab_w_out, p.Wout0, 1024, 1024, 1024);
  add(p.tab0, p.s5_wglu, p.Wglu, 512, 512, 512);
  add(p.tab0, p.cd_w_in, p.Win1, 1024, 2816, 2816);
  add(p.tab0, p.cd_w_out, p.Wout1, 1024, 1024, 1024);
  add(p.tab0, p.rw2, p.Rw2t, 64, 512, 512);
  add(p.tab0, p.ra2, p.Ra2t, 64, 512, 512);
  add(p.tab0, p.rg2, p.Rg2t, 128, 512, 512);
  p.ntab0 = nt; p.ntiles0 = tiles;
  nt = 0; tiles = 0;
  add(p.tab1, p.w1 + (size_t)1024 * 4096, p.W1, 1024, 4096, 4096);
  add(p.tab1, p.w2 + (size_t)1024 * 4096, p.W2, 4096, 1024, 1024);
  add(p.tab1, p.wq + MB, p.Wq, 1024, 1024, 1024);
  add(p.tab1, p.wk + MB, p.Wk, 1024, 1024, 1024);
  add(p.tab1, p.wv + MB, p.Wv, 1024, 1024, 1024);
  add(p.tab1, p.wo + MB, p.Wo, 1024, 1024, 1024);
  p.ntab1 = nt; p.ntiles1 = tiles;

#ifdef MULTI_LAUNCH
  for (int ph = 0; ph < 28; ph++) {
    int lo = ph, hi = ph + 1;
    hipLaunchKernelGGL(mega, dim3(grid_blocks), dim3(NTHR), 0, stream, p, lo, hi);
  }
#else
  {
    int n = 0;
    for (int ph = 0; ph < 28; ph++) {
      p.seq[n++] = (unsigned char)ph;
#ifdef PROBE_MASK
      if ((PROBE_MASK >> ph) & 1u) p.seq[n++] = (unsigned char)ph;
#endif
    }
    p.nseq = n;
  }
  int lo = 0, hi = p.nseq;
  void* args[] = {&p, &lo, &hi};
  hipError_t e = hipLaunchCooperativeKernel((void*)mega, dim3(grid_blocks), dim3(NTHR), args, 0, stream);
  if (e != hipSuccess) fprintf(stderr, "coop launch failed: %s (grid %d)\n", hipGetErrorString(e), grid_blocks);
#endif
}
```

```cpp
#include <hip/hip_runtime.h>
#include <hip/hip_cooperative_groups.h>
#include <cstdio>
#include <cstdint>
#include <cstring>
namespace cg = cooperative_groups;

typedef unsigned short u16;
typedef __attribute__((ext_vector_type(8))) short bf16x8;
typedef __attribute__((ext_vector_type(4))) float f32x4;

#define T_TOK 16384
#define SEQL 4096
#define NTHR 256

typedef float float2v_ __attribute__((ext_vector_type(2)));
typedef __bf16 bf16x2v_ __attribute__((ext_vector_type(2)));
__device__ __forceinline__ unsigned pack2(float lo, float hi) {
  float2v_ f = {lo, hi};
  bf16x2v_ b = __builtin_convertvector(f, bf16x2v_);
  return __builtin_bit_cast(unsigned, b);
}
__device__ __forceinline__ float bflo(unsigned u) { return __uint_as_float(u << 16); }
__device__ __forceinline__ float bfhi(unsigned u) { return __uint_as_float(u & 0xffff0000u); }
__device__ __forceinline__ float bf2f(u16 h) { return __uint_as_float(((unsigned)h) << 16); }
__device__ __forceinline__ u16 f2bf(float f) { return (u16)(pack2(f, 0.f) & 0xffffu); }
__device__ __forceinline__ void unpack4(uint2 u, float* f) { f[0] = bflo(u.x); f[1] = bfhi(u.x); f[2] = bflo(u.y); f[3] = bfhi(u.y); }
__device__ __forceinline__ uint2 pack4(float a, float b, float c, float d) { return make_uint2(pack2(a, b), pack2(c, d)); }
__device__ __forceinline__ bf16x8 pack8(const float* f) {
  union { bf16x8 v; unsigned u[4]; } r;
  r.u[0] = pack2(f[0], f[1]); r.u[1] = pack2(f[2], f[3]); r.u[2] = pack2(f[4], f[5]); r.u[3] = pack2(f[6], f[7]);
  return r.v;
}
__device__ __forceinline__ void unpack8(uint4 u, float* f) {
  f[0] = bflo(u.x); f[1] = bfhi(u.x); f[2] = bflo(u.y); f[3] = bfhi(u.y);
  f[4] = bflo(u.z); f[5] = bfhi(u.z); f[6] = bflo(u.w); f[7] = bfhi(u.w);
}
__device__ __forceinline__ float frcp(float x) { return __builtin_amdgcn_rcpf(x); }
__device__ __forceinline__ float sigmoidf_(float x) { return frcp(1.f + __expf(-x)); }
__device__ __forceinline__ float softplusf_(float z) { return fmaxf(z, 0.f) + __logf(1.f + __expf(-fabsf(z))); }
__device__ __forceinline__ float logsigmoidf_(float x) { return fminf(x, 0.f) - __logf(1.f + __expf(-fabsf(x))); }
__device__ __forceinline__ float fast_tanh(float x) { return 1.f - 2.f * frcp(1.f + __expf(2.f * x)); }
__device__ __forceinline__ float gelu_tanh(float x) {
  const float u2 = 1.5957691216057308f * (x + 0.044715f * x * x * x);
  return x * frcp(1.f + __expf(-u2));
}
__device__ __forceinline__ float xadd16(float x) { unsigned a = __float_as_uint(x); auto r = __builtin_amdgcn_permlane16_swap(a, a, false, false); return __uint_as_float(r[0]) + __uint_as_float(r[1]); }
__device__ __forceinline__ float xadd32(float x) { unsigned a = __float_as_uint(x); auto r = __builtin_amdgcn_permlane32_swap(a, a, false, false); return __uint_as_float(r[0]) + __uint_as_float(r[1]); }
__device__ __forceinline__ float xmax16(float x) { unsigned a = __float_as_uint(x); auto r = __builtin_amdgcn_permlane16_swap(a, a, false, false); return fmaxf(__uint_as_float(r[0]), __uint_as_float(r[1])); }
__device__ __forceinline__ float xmax32(float x) { unsigned a = __float_as_uint(x); auto r = __builtin_amdgcn_permlane32_swap(a, a, false, false); return fmaxf(__uint_as_float(r[0]), __uint_as_float(r[1])); }
template <int CTRL>
__device__ __forceinline__ float dppf(float x) {
  return __int_as_float(__builtin_amdgcn_mov_dpp(__float_as_int(x), CTRL, 0xf, 0xf, true));
}
__device__ __forceinline__ float sum16(float x) {
  x += dppf<0xB1>(x);
  x += dppf<0x4E>(x);
  x += dppf<0x141>(x);
  x += dppf<0x140>(x);
  return x;
}
__device__ __forceinline__ int ltid() { int t = threadIdx.x; asm volatile("" : "+v"(t)); return t; }
__device__ __forceinline__ float wave_sum(float v) {
  v = sum16(v);
  return xadd32(xadd16(v));
}
#define MFMA16(a, b, c) __builtin_amdgcn_mfma_f32_16x16x32_bf16((a), (b), (c), 0, 0, 0)

struct TDesc { const float* src; u16* dst; int K, N, Npad, t0; };
#define MAXT 40
struct P {
  const float *x, *mem, *norm_gain, *wq, *wk, *wv, *wo, *w1, *w2;
  const float *ab_w_in, *gla_w2, *gla_bd, *gla_ng, *s5_lre, *s5_lim, *s5_ls, *s5_bre, *s5_bim, *s5_cre, *s5_cim, *s5_d,
      *s5_wglu, *s5_bglu, *ab_w_out;
  const float *cd_w_in, *mu, *w0, *rw2, *a0, *ra2, *rg2, *k_k, *k_a, *r_k, *ln_g, *ln_b, *conv_w, *conv_b, *lw_a, *lb_a,
      *lw_x, *lb_x, *llam, *cd_w_out;
  float* out;
  u16 *Wq, *Wk, *Wv, *Wo, *W1, *W2;
  u16 *Win0, *Wout0, *Wglu, *S5W1, *S5W2, *Win1, *Wout1, *Rw2t, *Ra2t, *Rg2t, *Lwt;
  u16 *memn, *Kp, *Vt;
  u16 *A, *B;
  char* H;
  float* gdec;
  float* c3buf;
  unsigned* bar;
  TDesc tab0[MAXT];
  TDesc tab1[8];
  int ntab0, ntiles0, ntab1, ntiles1;
  int nseq, pad_;
  unsigned char seq[64];
};

#define GST 32
#define GSW(row, q) ((((q) ^ ((0 - (((row) & 15) >> 2)) & 3))) * 8)
template <class AL, class EP>
__device__ __forceinline__ void gemm_tile(const AL& al, const u16* __restrict__ Wt, int K, int m0, int n0, int nt,
                                          const EP& ep, u16* sm) {
  const int tid = ltid(), lane = tid & 63, wave = tid >> 6;
  const int wm = wave >> 1, wn = wave & 1;
  u16* As = sm;
  u16* Bs = sm + 2 * 128 * GST;
  const int lr0 = tid >> 2, lkc = (tid & 3) * 8;
  const int lsw = GSW(lr0, tid & 3);
  const int rsw = GSW(lane & 15, lane >> 4);
  f32x4 acc[4][4];
#pragma unroll
  for (int i = 0; i < 4; i++)
#pragma unroll
    for (int j = 0; j < 4; j++) acc[i][j] = (f32x4){0.f, 0.f, 0.f, 0.f};
  const u16* wp0 = Wt + (size_t)(n0 + lr0) * K + lkc;
  const u16* wp1 = Wt + (size_t)(n0 + lr0 + 64) * K + lkc;
  const int nk = K >> 5;
  bf16x8 e0, e1, e2, e3;
  bf16x8 o0, o1, o2, o3;
#define G_LOAD(r0, r1, r2, r3, kt_)                                                    \
  { const int k0_ = (kt_) * 32; r0 = al(m0 + lr0, k0_ + lkc, nt); r1 = al(m0 + lr0 + 64, k0_ + lkc, nt); \
    r2 = *(const bf16x8*)(wp0 + k0_); r3 = *(const bf16x8*)(wp1 + k0_); }
#define G_STORE(r0, r1, r2, r3, buf_)                                                  \
  { u16* An_ = As + (buf_) * 128 * GST; u16* Bn_ = Bs + (buf_) * 128 * GST;             \
    *(bf16x8*)(An_ + lr0 * GST + lsw) = r0; *(bf16x8*)(An_ + (lr0 + 64) * GST + lsw) = r1; \
    *(bf16x8*)(Bn_ + lr0 * GST + lsw) = r2; *(bf16x8*)(Bn_ + (lr0 + 64) * GST + lsw) = r3; }
#define G_COMPUTE(buf_)                                                                \
  { const u16* Ac_ = As + (buf_) * 128 * GST; const u16* Bc_ = Bs + (buf_) * 128 * GST; \
    bf16x8 wf[4], xf[4];                                                               \
    _Pragma("unroll") for (int i = 0; i < 4; i++) wf[i] = *(const bf16x8*)(Bc_ + (wn * 64 + i * 16 + (lane & 15)) * GST + rsw); \
    _Pragma("unroll") for (int i = 0; i < 4; i++) xf[i] = *(const bf16x8*)(Ac_ + (wm * 64 + i * 16 + (lane & 15)) * GST + rsw); \
    _Pragma("unroll") for (int i = 0; i < 4; i++)                                      \
      _Pragma("unroll") for (int j = 0; j < 4; j++) acc[i][j] = MFMA16(wf[i], xf[j], acc[i][j]); }
  G_LOAD(e0, e1, e2, e3, 0);
  G_LOAD(o0, o1, o2, o3, 1);
  G_STORE(e0, e1, e2, e3, 0);
  if (nk > 2) G_LOAD(e0, e1, e2, e3, 2);
  __syncthreads();
  for (int kt = 0; kt < nk; kt += 2) {
    G_COMPUTE(0);
    G_STORE(o0, o1, o2, o3, 1);
    if (kt + 3 < nk) G_LOAD(o0, o1, o2, o3, kt + 3);
    __syncthreads();
    G_COMPUTE(1);
    if (kt + 2 < nk) {
      G_STORE(e0, e1, e2, e3, 0);
      if (kt + 4 < nk) G_LOAD(e0, e1, e2, e3, kt + 4);
    }
    __syncthreads();
  }
#undef G_LOAD
#undef G_STORE
#undef G_COMPUTE
  ep(acc, m0 + wm * 64, n0 + wn * 64, lane, nt);
}

struct ALbf {
  const u16* A; int lda;
  __device__ __forceinline__ bf16x8 operator()(int m, int k, int) const { return *(const bf16x8*)(A + (size_t)m * lda + k); }
};
#define GB_STAGE_EL (384 * GST)
#define WAIT_V(n) asm volatile("s_waitcnt vmcnt(%0)" ::"n"(n) : "memory")
#define RAW_BARRIER() do { asm volatile("s_waitcnt lgkmcnt(0)" ::: "memory"); __builtin_amdgcn_s_barrier(); } while (0)
typedef __attribute__((address_space(3))) unsigned lds_u32;
__device__ __forceinline__ void gb_issue(const u16* ga, const u16* gw, size_t a64, size_t w64, int ko, u16* __restrict__ wr, int wave) {
#pragma unroll
  for (int i = 0; i < 4; i++)
    __builtin_amdgcn_global_load_lds((const unsigned*)(ga + i * a64 + ko), (lds_u32*)(wr + (i * 4 + wave) * 512), 16, 0, 0);
#pragma unroll
  for (int i = 0; i < 2; i++)
    __builtin_amdgcn_global_load_lds((const unsigned*)(gw + i * w64 + ko), (lds_u32*)(wr + 256 * GST + (i * 4 + wave) * 512), 16, 0, 0);
}
__device__ __forceinline__ void gb_step(const u16* ga, const u16* gw, size_t a64, size_t w64, int ko, bool issue,
                                        const u16* __restrict__ rd, u16* __restrict__ wr, int wave, int wm, int wn, int lane, int rsw,
                                        f32x4 (&acc)[4][8]) {
  if (issue) {
#pragma unroll
    for (int i = 0; i < 4; i++)
      __builtin_amdgcn_global_load_lds((const unsigned*)(ga + i * a64 + ko), (lds_u32*)(wr + (i * 4 + wave) * 512), 16, 0, 0);
#pragma unroll
    for (int i = 0; i < 2; i++)
      __builtin_amdgcn_global_load_lds((const unsigned*)(gw + i * w64 + ko), (lds_u32*)(wr + 256 * GST + (i * 4 + wave) * 512), 16, 0, 0);
  }
  const unsigned rdb = (unsigned)(size_t)(__attribute__((address_space(3))) const char*)rd;
  const unsigned ab = rdb + (unsigned)(((wm * 128 + (lane & 15)) * GST + rsw) * 2);
  const int wr0 = wn * 64 + (((lane & 15) >> 2) << 3) + (lane & 3);
  const unsigned bb0 = rdb + (unsigned)((256 * GST + wr0 * GST + GSW(wr0, lane >> 4)) * 2);
  const unsigned bb1 = rdb + (unsigned)((256 * GST + (wr0 + 4) * GST + GSW(wr0 + 4, lane >> 4)) * 2);
  bf16x8 wf0, wf1, wf2, wf3, xf0, xf1, xf2, xf3, xf4, xf5, xf6, xf7;
#define DSR(dst, addr, off) asm volatile("ds_read_b128 %0, %1 offset:%2" : "=v"(dst) : "v"(addr), "n"(off) : "memory")
  DSR(wf0, bb0, 0); DSR(wf1, bb1, 0); DSR(wf2, bb0, 2048); DSR(wf3, bb1, 2048);
  DSR(xf0, ab, 0); DSR(xf1, ab, 1024); DSR(xf2, ab, 2048); DSR(xf3, ab, 3072);
  DSR(xf4, ab, 4096); DSR(xf5, ab, 5120); DSR(xf6, ab, 6144); DSR(xf7, ab, 7168);
#undef DSR
#define MM(j, xf)                                                                     \
  acc[0][j] = MFMA16(wf0, xf, acc[0][j]); acc[1][j] = MFMA16(wf1, xf, acc[1][j]);      \
  acc[2][j] = MFMA16(wf2, xf, acc[2][j]); acc[3][j] = MFMA16(wf3, xf, acc[3][j]);
  asm volatile("s_waitcnt lgkmcnt(7)" : "+v"(wf0), "+v"(wf1), "+v"(wf2), "+v"(wf3), "+v"(xf0) : : "memory");
  MM(0, xf0)
  asm volatile("s_waitcnt lgkmcnt(6)" : "+v"(xf1) : : "memory");
  MM(1, xf1)
  asm volatile("s_waitcnt lgkmcnt(5)" : "+v"(xf2) : : "memory");
  MM(2, xf2)
  asm volatile("s_waitcnt lgkmcnt(4)" : "+v"(xf3) : : "memory");
  MM(3, xf3)
  asm volatile("s_waitcnt lgkmcnt(3)" : "+v"(xf4) : : "memory");
  MM(4, xf4)
  asm volatile("s_waitcnt lgkmcnt(2)" : "+v"(xf5) : : "memory");
  MM(5, xf5)
  asm volatile("s_waitcnt lgkmcnt(1)" : "+v"(xf6) : : "memory");
  MM(6, xf6)
  asm volatile("s_waitcnt lgkmcnt(0)" : "+v"(xf7) : : "memory");
  MM(7, xf7)
#undef MM
}
template <class F>
__device__ __forceinline__ void gemm_big(const ALbf& al, const u16* __restrict__ Wt, int K, int m0, int n0, const F& f, u16* sm) {
  const int tid = ltid(), lane = tid & 63, wave = tid >> 6;
  const int wm = wave >> 1, wn = wave & 1;
  const int rsw = GSW(lane & 15, lane >> 4);
  f32x4 acc[4][8];
#pragma unroll
  for (int i = 0; i < 4; i++)
#pragma unroll
    for (int j = 0; j < 8; j++) acc[i][j] = (f32x4){0.f, 0.f, 0.f, 0.f};
  const int srow = lane >> 2;
  const int scol = ((lane & 3) ^ ((0 - (srow >> 2)) & 3)) * 8;
  const u16* ga = al.A + (size_t)(m0 + wave * 16 + srow) * al.lda + scol;
  const u16* gw = Wt + (size_t)(n0 + wave * 16 + srow) * K + scol;
  const size_t a64 = (size_t)64 * al.lda, w64 = (size_t)64 * K;
  const int nk = K >> 5;
  WAIT_V(0);
  gb_issue(ga, gw, a64, w64, 0, sm, wave);
  gb_issue(ga, gw, a64, w64, 32, sm + GB_STAGE_EL, wave);
  WAIT_V(6);
  RAW_BARRIER();
  int cur = 0;
  for (int kt = 0; kt < nk; ++kt) {
    const int nxt2 = (cur >= 1) ? cur - 1 : 2;
    gb_step(ga, gw, a64, w64, (kt + 2) * 32, kt + 2 < nk, sm + cur * GB_STAGE_EL, sm + nxt2 * GB_STAGE_EL, wave, wm, wn, lane, rsw, acc);
    if (kt + 2 < nk) WAIT_V(6); else WAIT_V(0);
    RAW_BARRIER();
    cur = (cur == 2) ? 0 : cur + 1;
  }
#pragma unroll
  for (int pq = 0; pq < 2; pq++)
#pragma unroll
    for (int j = 0; j < 8; j++)
      f(m0 + wm * 128 + j * 16 + (lane & 15), n0 + wn * 64 + pq * 32 + (lane >> 4) * 8, acc[2 * pq][j], acc[2 * pq + 1][j]);
}
__device__ __forceinline__ uint4 pack8v(const f32x4& a, const f32x4& b) {
  return make_uint4(pack2(a[0], a[1]), pack2(a[2], a[3]), pack2(b[0], b[1]), pack2(b[2], b[3]));
}
template <class F>
__device__ __forceinline__ void gemm_big_jobs(const ALbf& al, const u16* Wt, int K, int Nt, const F& f, u16* sm, int job0, int jstride) {
  for (int t = job0; t < 64 * Nt; t += jstride) gemm_big(al, Wt, K, (t & 63) * 256, (t >> 6) * 128, f, sm);
}

struct ALf32 {
  const float* A; int lda;
  __device__ __forceinline__ bf16x8 operator()(int m, int k, int) const {
    const float4* p = (const float4*)(A + (size_t)m * lda + k);
    float4 a = p[0], b = p[1];
    float f[8] = {a.x, a.y, a.z, a.w, b.x, b.y, b.z, b.w};
    return pack8(f);
  }
};
template <class F>
struct EPgen {
  F f;
  __device__ __forceinline__ void operator()(f32x4 (&acc)[4][4], int mw, int nw, int lane, int nt) const {
#pragma unroll
    for (int i = 0; i < 4; i++)
#pragma unroll
      for (int j = 0; j < 4; j++) f(mw + j * 16 + (lane & 15), nw + i * 16 + (lane >> 4) * 4, acc[i][j], nt);
  }
};

template <class AL, class EP>
__device__ __forceinline__ void gemm_jobs(const AL& al, const u16* Wt, int K, int Mt, int Nt, const EP& ep, u16* sm,
                                          int job0, int jstride) {
  for (int t = job0; t < Mt * Nt; t += jstride) {
    int mt = t % Mt, nt = t / Mt;
    gemm_tile(al, Wt, K, mt * 128, nt * 128, nt, ep, sm);
  }
}

__device__ __forceinline__ void transpose_tile(const TDesc& d, int tile, float* sm) {
  const int ktn = d.K >> 6;
  const int kt = tile % ktn, ntl = tile / ktn;
  const int k0 = kt * 64, n0 = ntl * 64;
  const int tid = ltid();
  __syncthreads();
#pragma unroll
  for (int i = 0; i < 16; i++) {
    int e = tid + i * 256;
    int kk = e >> 6, nn = e & 63;
    const int nc = n0 + nn;
    float v = __builtin_nontemporal_load(&d.src[(size_t)(k0 + kk) * d.N + (nc < d.N ? nc : d.N - 1)]);
    sm[kk * 65 + nn] = (nc < d.N) ? v : 0.f;
  }
  __syncthreads();
#pragma unroll
  for (int i = 0; i < 2; i++) {
    int e = tid + i * 256;
    int nn = e >> 3, kc = (e & 7) * 8;
    float f[8];
#pragma unroll
    for (int q = 0; q < 8; q++) f[q] = sm[(kc + q) * 65 + nn];
    *(bf16x8*)(d.dst + (size_t)(n0 + nn) * d.K + k0 + kc) = pack8(f);
  }
}
__device__ __forceinline__ void transpose_jobs(const TDesc* tab, int ntab, int ntiles, float* sm, int job0, int jstride) {
  for (int t = job0; t < ntiles; t += jstride) {
    int di = 0;
    for (int i = 1; i < ntab; i++)
      if (t >= tab[i].t0) di = i;
    transpose_tile(tab[di], t - tab[di].t0, sm);
  }
}

__device__ __forceinline__ void lru_weight_job(const P& p, int h) {
  for (int e = ltid(); e < 128 * 64; e += 256) {
    const int r = e >> 6, k = e & 63;
    const int ch = (r >> 6) * 32 + ((r >> 5) & 1) * 16 + (r & 15);
    const float* src = ((r >> 4) & 1) ? p.lw_x : p.lw_a;
    p.Lwt[(size_t)(h * 128 + r) * 64 + k] = f2bf(src[h * 4096 + k * 64 + ch]);
  }
}

__device__ __forceinline__ void norm_rows(const float* in, const float* gain, u16* outb, int nrows, int job0w, int jstridew) {
  const int lane = ltid() & 63;
  for (int r = job0w; r < nrows; r += jstridew) {
    const float4* ip = (const float4*)(in + (size_t)r * 1024);
    float4 v[4];
    float ss = 0.f;
#pragma unroll
    for (int i = 0; i < 4; i++) {
      { const f32x4 t_ = __builtin_nontemporal_load((const f32x4*)ip + lane + i * 64); v[i] = make_float4(t_[0], t_[1], t_[2], t_[3]); }
      ss += v[i].x * v[i].x + v[i].y * v[i].y + v[i].z * v[i].z + v[i].w * v[i].w;
    }
    ss = wave_sum(ss);
    float sc = rsqrtf(ss * (1.f / 1024.f) + 1e-6f);
#pragma unroll
    for (int i = 0; i < 4; i++) {
      float4 g = ((const float4*)gain)[lane + i * 64];
      *(uint2*)(outb + (size_t)r * 1024 + (lane + i * 64) * 4) =
          pack4(v[i].x * sc * g.x, v[i].y * sc * g.y, v[i].z * sc * g.z, v[i].w * sc * g.w);
    }
  }
}
#define RN_R 2
__device__ __forceinline__ void resid_norm(const float* hin, const u16* y, const float* gpost, const float* gpre, float* hout, u16* hn,
                           int job0w, int jstridew) {
  const int lane = ltid() & 63;
  for (int r0 = job0w * RN_R; r0 < T_TOK; r0 += jstridew * RN_R) {
    uint2 yu[RN_R][4];
    float4 h4[RN_R][4];
#pragma unroll
    for (int q = 0; q < RN_R; q++)
#pragma unroll
      for (int i = 0; i < 4; i++) {
        { typedef unsigned u32x2_ __attribute__((ext_vector_type(2)));
          const u32x2_ t_ = __builtin_nontemporal_load((const u32x2_*)(y + (size_t)(r0 + q) * 1024 + (lane + i * 64) * 4));
          yu[q][i] = make_uint2(t_[0], t_[1]); }
        {
          const f32x4 t_ = __builtin_nontemporal_load((const f32x4*)(hin + (size_t)(r0 + q) * 1024) + lane + i * 64);
          h4[q][i] = make_float4(t_[0], t_[1], t_[2], t_[3]); }
      }
    float4 gp[4];
#pragma unroll
    for (int i = 0; i < 4; i++) gp[i] = ((const float4*)gpost)[lane + i * 64];
#pragma unroll
    for (int q = 0; q < RN_R; q++) {
      const int r = r0 + q;
      float yv[16];
      float ss = 0.f;
#pragma unroll
      for (int i = 0; i < 4; i++) {
        unpack4(yu[q][i], yv + i * 4);
#pragma unroll
        for (int e = 0; e < 4; e++) ss += yv[i * 4 + e] * yv[i * 4 + e];
      }
      ss = wave_sum(ss);
      const float sc = rsqrtf(ss * (1.f / 1024.f) + 1e-6f);
      float hv[16];
      float s2 = 0.f;
#pragma unroll
      for (int i = 0; i < 4; i++) {
        hv[i * 4 + 0] = h4[q][i].x + yv[i * 4 + 0] * sc * gp[i].x;
        hv[i * 4 + 1] = h4[q][i].y + yv[i * 4 + 1] * sc * gp[i].y;
        hv[i * 4 + 2] = h4[q][i].z + yv[i * 4 + 2] * sc * gp[i].z;
        hv[i * 4 + 3] = h4[q][i].w + yv[i * 4 + 3] * sc * gp[i].w;
#pragma unroll
        for (int e = 0; e < 4; e++) s2 += hv[i * 4 + e] * hv[i * 4 + e];
        __builtin_nontemporal_store((f32x4){hv[i * 4], hv[i * 4 + 1], hv[i * 4 + 2], hv[i * 4 + 3]}, (f32x4*)(hout + (size_t)r * 1024) + lane + i * 64);
      }
      if (gpre) {
        s2 = wave_sum(s2);
        const float sc2 = rsqrtf(s2 * (1.f / 1024.f) + 1e-6f);
#pragma unroll
        for (int i = 0; i < 4; i++) {
          float4 g = ((const float4*)gpre)[lane + i * 64];
          *(uint2*)(hn + (size_t)r * 1024 + (lane + i * 64) * 4) =
              pack4(hv[i * 4] * sc2 * g.x, hv[i * 4 + 1] * sc2 * g.y, hv[i * 4 + 2] * sc2 * g.z, hv[i * 4 + 3] * sc2 * g.w);
        }
      }
    }
  }
}

__device__ __forceinline__ void s5_precompute(const P& p, int g, float* sm) {
  float* lp_re = sm;
  float* lp_im = lp_re + 17 * 64;
  float* bb_re = lp_im + 17 * 64;
  float* bb_im = bb_re + 1024;
  float* c_re = bb_im + 1024;
  float* c_im = c_re + 1024;
  float* Kt = c_im + 1024;
  const int tid = ltid();
  __syncthreads();
  const float delta = expf(p.s5_ls[g]);
  for (int e = tid; e < 17 * 64; e += 256) {
    int tau = e >> 6, n = e & 63;
    float lr = fminf(p.s5_lre[g * 64 + n], -1e-4f), li = p.s5_lim[g * 64 + n];
    float a = tau * delta * lr, b = tau * delta * li;
    float s, c;
    sincosf(b, &s, &c);
    float ea = expf(a);
    lp_re[e] = ea * c; lp_im[e] = ea * s;
  }
  for (int e = tid; e < 1024; e += 256) {
    int n = e >> 4;
    float lr = fminf(p.s5_lre[g * 64 + n], -1e-4f), li = p.s5_lim[g * 64 + n];
    float a = delta * lr, b = delta * li;
    float s, c, sh, ch;
    sincosf(b, &s, &c);
    sincosf(0.5f * b, &sh, &ch);
    float zr = expm1f(a) * c - 2.f * sh * sh, zi = expf(a) * s;
    float den = 1.f / (lr * lr + li * li);
    float fr = (zr * lr + zi * li) * den, fi = (zi * lr - zr * li) * den;
    float br = p.s5_bre[(size_t)g * 1024 + e], bi = p.s5_bim[(size_t)g * 1024 + e];
    bb_re[e] = fr * br - fi * bi; bb_im[e] = fr * bi + fi * br;
    c_re[e] = p.s5_cre[(size_t)g * 1024 + e]; c_im[e] = p.s5_cim[(size_t)g * 1024 + e];
  }
  __syncthreads();
  {
    const int c = (tid >> 4) & 15, cp = tid & 15;
    float kacc[16];
#pragma unroll
    for (int t = 0; t < 16; t++) kacc[t] = 0.f;
    for (int n = 0; n < 64; n++) {
      const float cr = c_re[c * 64 + n], ci = c_im[c * 64 + n], br = bb_re[n * 16 + cp], bi = bb_im[n * 16 + cp];
      const float Pn = cr * br - ci * bi, Qn = cr * bi + ci * br;
#pragma unroll
      for (int t = 0; t < 16; t++) kacc[t] += lp_re[t * 64 + n] * Pn - lp_im[t * 64 + n] * Qn;
    }
#pragma unroll
    for (int t = 0; t < 16; t++) Kt[t * 256 + tid] = kacc[t];
  }
  __syncthreads();
  u16* W1 = p.S5W1 + (size_t)g * 384 * 256;
  for (int e = tid; e < 384 * 32; e += 256) {
    int j = e >> 5, k0 = (e & 31) * 8;
    int s = k0 >> 4, cp0 = k0 & 15;
    float f[8];
    if (j < 256) {
      int t = j >> 4, c = j & 15;
#pragma unroll
      for (int q = 0; q < 8; q++) f[q] = (s <= t) ? Kt[((t - s) * 16 + c) * 16 + cp0 + q] : 0.f;
    } else {
      int n = (j - 256) & 63;
      bool im = (j - 256) >= 64;
      float lr = lp_re[(15 - s) * 64 + n], li = lp_im[(15 - s) * 64 + n];
#pragma unroll
      for (int q = 0; q < 8; q++) {
        float br = bb_re[n * 16 + cp0 + q], bi = bb_im[n * 16 + cp0 + q];
        f[q] = im ? (lr * bi + li * br) : (lr * br - li * bi);
      }
    }
    *(bf16x8*)(W1 + (size_t)j * 256 + k0) = pack8(f);
  }
  u16* W2 = p.S5W2 + (size_t)g * 256 * 128;
  for (int e = tid; e < 256 * 16; e += 256) {
    int j = e >> 4, k0 = (e & 15) * 8;
    int t = j >> 4, c = j & 15;
    float f[8];
#pragma unroll
    for (int q = 0; q < 8; q++) {
      int k = k0 + q;
      int n = k & 63;
      float lr = lp_re[(t + 1) * 64 + n], li = lp_im[(t + 1) * 64 + n];
      float cr = c_re[c * 64 + n], ci = c_im[c * 64 + n];
      f[q] = (k < 64) ? (cr * lr - ci * li) : -(cr * li + ci * lr);
    }
    *(bf16x8*)(W2 + (size_t)j * 128 + k0) = pack8(f);
  }
}

#define PROJ0_LD 2064
__device__ __forceinline__ void gla_cumdecay(const P& p, const u16* proj, int t0, int h, float* bl, float* dl, float* w2s) {
  const int tid = ltid();
  for (int e = tid; e < 1024; e += 256) {
    int t = e >> 4, r = e & 15;
    dl[e] = bf2f(proj[(size_t)(t0 + t) * PROJ0_LD + 1536 + r]);
    int rr = e >> 6, d = e & 63;
    w2s[e] = p.gla_w2[rr * 256 + h * 64 + d];
  }
  __syncthreads();
  const int d = tid & 63, q = tid >> 6;
  const float bd = p.gla_bd[h * 64 + d];
  float run = 0.f;
  float loc[16];
#pragma unroll
  for (int i = 0; i < 16; i++) {
    int t = q * 16 + i;
    float x = bd;
#pragma unroll
    for (int r = 0; r < 16; r++) x += dl[t * 16 + r] * w2s[r * 64 + d];
    run += logsigmoidf_(x) * (1.f / 16.f);
    loc[i] = run;
  }
  bl[(q * 16 + 15) * 64 + d] = run;
  __syncthreads();
  float pre = 0.f;
  for (int qq = 0; qq < q; qq++) pre += bl[(qq * 16 + 15) * 64 + d];
  __syncthreads();
#pragma unroll
  for (int i = 0; i < 16; i++) bl[(q * 16 + i) * 64 + d] = loc[i] + pre;
  __syncthreads();
}

#define GL_ST 72
__device__ __forceinline__ void gla_state_job(const P& p, int job, char* smc) {
  const u16* proj = (const u16*)p.H;
  float* stbuf = (float*)(p.H + (size_t)T_TOK * PROJ0_LD * 2);
  const int h = job & 3, c = (job >> 2) & 63, b = job >> 8;
  const int t0 = b * SEQL + c * 64;
  float* bl = (float*)smc;
  u16* kstT = (u16*)(smc + 16384);
  u16* VtL = kstT + 64 * GL_ST;
  float* dl = (float*)(VtL + 128 * GL_ST);
  float* w2s = dl + 1024;
  const int tid = ltid(), lane = tid & 63, wave = tid >> 6;
  __syncthreads();
  gla_cumdecay(p, proj, t0, h, bl, dl, w2s);
  {
    const int s = tid >> 2, ds = (tid & 3) * 16;
    const u16* kp = proj + (size_t)(t0 + s) * PROJ0_LD + 256 + h * 64 + ds;
    float kf[16];
    unpack8(*(const uint4*)kp, kf);
    unpack8(*(const uint4*)(kp + 8), kf + 8);
#pragma unroll
    for (int i = 0; i < 16; i++) {
      int d = ds + i;
      float v = kf[i] * __expf(bl[63 * 64 + d] - bl[s * 64 + d]);
      kstT[d * GL_ST + s] = f2bf(v);
    }
    const int vs = (tid & 3) * 32;
    const u16* vp = proj + (size_t)(t0 + s) * PROJ0_LD + 512 + h * 128 + vs;
#pragma unroll
    for (int i = 0; i < 4; i++) {
      uint4 u = *(const uint4*)(vp + i * 8);
      VtL[(vs + i * 8 + 0) * GL_ST + s] = (u16)(u.x & 0xffff); VtL[(vs + i * 8 + 1) * GL_ST + s] = (u16)(u.x >> 16);
      VtL[(vs + i * 8 + 2) * GL_ST + s] = (u16)(u.y & 0xffff); VtL[(vs + i * 8 + 3) * GL_ST + s] = (u16)(u.y >> 16);
      VtL[(vs + i * 8 + 4) * GL_ST + s] = (u16)(u.z & 0xffff); VtL[(vs + i * 8 + 5) * GL_ST + s] = (u16)(u.z >> 16);
      VtL[(vs + i * 8 + 6) * GL_ST + s] = (u16)(u.w & 0xffff); VtL[(vs + i * 8 + 7) * GL_ST + s] = (u16)(u.w >> 16);
    }
    if (tid < 64) p.gdec[((b * 4 + h) * 64 + c) * 64 + tid] = __expf(bl[63 * 64 + tid]);
  }
  __syncthreads();
  f32x4 acc[8];
#pragma unroll
  for (int i = 0; i < 8; i++) acc[i] = (f32x4){0.f, 0.f, 0.f, 0.f};
#pragma unroll
  for (int kb = 0; kb < 2; kb++) {
    bf16x8 a = *(const bf16x8*)(kstT + (wave * 16 + (lane & 15)) * GL_ST + kb * 32 + (lane >> 4) * 8);
#pragma unroll
    for (int vt = 0; vt < 8; vt++) {
      bf16x8 bb = *(const bf16x8*)(VtL + (vt * 16 + (lane & 15)) * GL_ST + kb * 32 + (lane >> 4) * 8);
      acc[vt] = MFMA16(a, bb, acc[vt]);
    }
  }
  float* sp = stbuf + ((size_t)((b * 4 + h) * 64 + c)) * 8192;
#pragma unroll
  for (int vt = 0; vt < 8; vt++) {
    int v = vt * 16 + (lane & 15), d = wave * 16 + (lane >> 4) * 4;
    *(float4*)(sp + v * 64 + d) = make_float4(acc[vt][0], acc[vt][1], acc[vt][2], acc[vt][3]);
  }
}
__device__ __forceinline__ void gla_scan_job(const P& p, int job) {
  float* stbuf = (float*)(p.H + (size_t)T_TOK * PROJ0_LD * 2);
  const int e = job * 256 + ltid();
  const int bh = e >> 13, vd = e & 8191, d = e & 63;
  float* sp = stbuf + (size_t)bh * 64 * 8192 + vd;
  const float* dp = p.gdec + bh * 64 * 64 + d;
  float s = 0.f;
  for (int c0 = 0; c0 < 64; c0 += 16) {
    float ds[16], dc[16];
#pragma unroll
    for (int i = 0; i < 16; i++) { ds[i] = sp[(size_t)(c0 + i) * 8192]; dc[i] = dp[(c0 + i) * 64]; }
#pragma unroll
    for (int i = 0; i < 16; i++) { sp[(size_t)(c0 + i) * 8192] = s; s = dc[i] * s + ds[i]; }
  }
}
__device__ __forceinline__ void gla_out_job(const P& p, int job, char* smc) {
  const u16* proj = (const u16*)p.H;
  const float* stbuf = (const float*)(p.H + (size_t)T_TOK * PROJ0_LD * 2);
  const int h = job & 3, c = (job >> 2) & 63, b = job >> 8;
  const int t0 = b * SEQL + c * 64;
  float* bl = (float*)smc;
  u16* qin = (u16*)(smc + 16384);
  u16* kin = qin + 64 * GL_ST;
  u16* VtL = kin + 64 * GL_ST;
  float* dl = (float*)(VtL + 128 * GL_ST);
  float* w2s = dl + 1024;
  const int tid = ltid(), lane = tid & 63, wave = tid >> 6;
  __syncthreads();
  gla_cumdecay(p, proj, t0, h, bl, dl, w2s);
  {
    const int s = tid >> 2, ds = (tid & 3) * 16;
    const u16* qp = proj + (size_t)(t0 + s) * PROJ0_LD + h * 64 + ds;
    const u16* kp = qp + 256;
    float qf[16], kf[16];
    unpack8(*(const uint4*)qp, qf); unpack8(*(const uint4*)(qp + 8), qf + 8);
    unpack8(*(const uint4*)kp, kf); unpack8(*(const uint4*)(kp + 8), kf + 8);
#pragma unroll
    for (int i = 0; i < 16; i++) {
      float bb = bl[s * 64 + ds + i];
      qf[i] = qf[i] * 0.125f * __expf(bb);
      kf[i] = kf[i] * __expf(-bb);
    }
    *(bf16x8*)(qin + s * GL_ST + ds) = pack8(qf);
    *(bf16x8*)(qin + s * GL_ST + ds + 8) = pack8(qf + 8);
    *(bf16x8*)(kin + s * GL_ST + ds) = pack8(kf);
    *(bf16x8*)(kin + s * GL_ST + ds + 8) = pack8(kf + 8);
    const int vs = (tid & 3) * 32;
    const u16* vp = proj + (size_t)(t0 + s) * PROJ0_LD + 512 + h * 128 + vs;
#pragma unroll
    for (int i = 0; i < 4; i++) {
      uint4 u = *(const uint4*)(vp + i * 8);
      VtL[(vs + i * 8 + 0) * GL_ST + s] = (u16)(u.x & 0xffff); VtL[(vs + i * 8 + 1) * GL_ST + s] = (u16)(u.x >> 16);
      VtL[(vs + i * 8 + 2) * GL_ST + s] = (u16)(u.y & 0xffff); VtL[(vs + i * 8 + 3) * GL_ST + s] = (u16)(u.y >> 16);
      VtL[(vs + i * 8 + 4) * GL_ST + s] = (u16)(u.z & 0xffff); VtL[(vs + i * 8 + 5) * GL_ST + s] = (u16)(u.z >> 16);
      VtL[(vs + i * 8 + 6) * GL_ST + s] = (u16)(u.w & 0xffff); VtL[(vs + i * 8 + 7) * GL_ST + s] = (u16)(u.w >> 16);
    }
  }
  __syncthreads();
  f32x4 S[4];
#pragma unroll
  for (int i = 0; i < 4; i++) S[i] = (f32x4){0.f, 0.f, 0.f, 0.f};
  bf16x8 qf0 = *(const bf16x8*)(qin + (wave * 16 + (lane & 15)) * GL_ST + (lane >> 4) * 8);
  bf16x8 qf1 = *(const bf16x8*)(qin + (wave * 16 + (lane & 15)) * GL_ST + 32 + (lane >> 4) * 8);
#pragma unroll
  for (int si = 0; si < 4; si++) {
    if (si <= wave) {
      bf16x8 k0 = *(const bf16x8*)(kin + (si * 16 + (lane & 15)) * GL_ST + (lane >> 4) * 8);
      bf16x8 k1 = *(const bf16x8*)(kin + (si * 16 + (lane & 15)) * GL_ST + 32 + (lane >> 4) * 8);
      S[si] = MFMA16(k0, qf0, S[si]);
      S[si] = MFMA16(k1, qf1, S[si]);
      if (si == wave) {
#pragma unroll
        for (int r = 0; r < 4; r++)
          if (((lane >> 4) * 4 + r) > (lane & 15)) S[si][r] = 0.f;
      }
    }
  }
  f32x4 O[8];
#pragma unroll
  for (int i = 0; i < 8; i++) O[i] = (f32x4){0.f, 0.f, 0.f, 0.f};
#pragma unroll
  for (int kb = 0; kb < 2; kb++) {
    union { bf16x8 v; unsigned u[4]; } pb;
    pb.u[0] = pack2(S[2 * kb][0], S[2 * kb][1]); pb.u[1] = pack2(S[2 * kb][2], S[2 * kb][3]);
    pb.u[2] = pack2(S[2 * kb + 1][0], S[2 * kb + 1][1]); pb.u[3] = pack2(S[2 * kb + 1][2], S[2 * kb + 1][3]);
#pragma unroll
    for (int vt = 0; vt < 8; vt++) {
      union { bf16x8 v; uint2 h[2]; } va;
      const u16* vr = VtL + (vt * 16 + (lane & 15)) * GL_ST + kb * 32 + (lane >> 4) * 4;
      va.h[0] = *(const uint2*)vr;
      va.h[1] = *(const uint2*)(vr + 16);
      O[vt] = MFMA16(va.v, pb.v, O[vt]);
    }
  }
  const float* sp = stbuf + ((size_t)((b * 4 + h) * 64 + c)) * 8192;
#pragma unroll
  for (int vt = 0; vt < 8; vt++) {
    const float* sr = sp + (vt * 16 + (lane & 15)) * 64 + (lane >> 4) * 8;
    float f[8];
    float4 a0 = *(const float4*)sr, a1 = *(const float4*)(sr + 4);
    f[0] = a0.x; f[1] = a0.y; f[2] = a0.z; f[3] = a0.w; f[4] = a1.x; f[5] = a1.y; f[6] = a1.z; f[7] = a1.w;
    O[vt] = MFMA16(pack8(f), qf0, O[vt]);
    a0 = *(const float4*)(sr + 32); a1 = *(const float4*)(sr + 36);
    f[0] = a0.x; f[1] = a0.y; f[2] = a0.z; f[3] = a0.w; f[4] = a1.x; f[5] = a1.y; f[6] = a1.z; f[7] = a1.w;
    O[vt] = MFMA16(pack8(f), qf1, O[vt]);
  }
  float ss = 0.f;
#pragma unroll
  for (int vt = 0; vt < 8; vt++)
#pragma unroll
    for (int r = 0; r < 4; r++) ss += O[vt][r] * O[vt][r];
  ss = xadd32(xadd16(ss));
  const float sc = rsqrtf(ss * (1.f / 128.f) + 1e-6f);
  const int tok = t0 + wave * 16 + (lane & 15);
#pragma unroll
  for (int vt = 0; vt < 8; vt++) {
    const int v = vt * 16 + (lane >> 4) * 4;
    float gt[4];
    unpack4(*(const uint2*)(proj + (size_t)tok * PROJ0_LD + 1024 + h * 128 + v), gt);
    float4 ng = *(const float4*)(p.gla_ng + h * 128 + v);
    float o0 = O[vt][0] * sc * ng.x * (gt[0] * sigmoidf_(gt[0]));
    float o1 = O[vt][1] * sc * ng.y * (gt[1] * sigmoidf_(gt[1]));
    float o2 = O[vt][2] * sc * ng.z * (gt[2] * sigmoidf_(gt[2]));
    float o3 = O[vt][3] * sc * ng.w * (gt[3] * sigmoidf_(gt[3]));
    *(uint2*)(p.A + (size_t)tok * 1024 + h * 128 + v) = pack4(o0, o1, o2, o3);
  }
}

__device__ __forceinline__ void s5_scan_job(const P& p, int job, float* sm) {
  const float* sloc = (const float*)p.B;
  u16* hin = p.B + (size_t)8 * 1024 * 1024;
  const int tid = ltid(), n = tid & 63, seg = tid >> 6;
  const int g = job & 31, b = job >> 5;
  const float delta = expf(p.s5_ls[g]);
  const float lr = fminf(p.s5_lre[g * 64 + n], -1e-4f), li = p.s5_lim[g * 64 + n];
  float sn, cs;
  sincosf(16.f * delta * li, &sn, &cs);
  const float ea = expf(16.f * delta * lr);
  const float mr = ea * cs, mi = ea * sn;
  float* segR = sm;
  float* segI = sm + 256;
  __syncthreads();
  const size_t base = ((size_t)((b * 256 + seg * 64) * 32 + g)) * 128 + n;
  float hr = 0.f, hi = 0.f;
  for (int c0 = 0; c0 < 64; c0 += 16) {
    float sr[16], si[16];
#pragma unroll
    for (int i = 0; i < 16; i++) { sr[i] = sloc[base + (size_t)(c0 + i) * 4096]; si[i] = sloc[base + (size_t)(c0 + i) * 4096 + 64]; }
#pragma unroll
    for (int i = 0; i < 16; i++) {
      const float nr = mr * hr - mi * hi + sr[i], ni = mr * hi + mi * hr + si[i];
      hr = nr; hi = ni;
    }
  }
  segR[seg * 64 + n] = hr; segI[seg * 64 + n] = hi;
  float pr = mr, pi = mi;
#pragma unroll
  for (int q = 0; q < 6; q++) { const float t = pr * pr - pi * pi; pi = 2.f * pr * pi; pr = t; }
  __syncthreads();
  hr = 0.f; hi = 0.f;
  for (int s2 = 0; s2 < seg; s2++) {
    const float nr = pr * hr - pi * hi + segR[s2 * 64 + n], ni = pr * hi + pi * hr + segI[s2 * 64 + n];
    hr = nr; hi = ni;
  }
  for (int c0 = 0; c0 < 64; c0 += 16) {
    float sr[16], si[16];
#pragma unroll
    for (int i = 0; i < 16; i++) { sr[i] = sloc[base + (size_t)(c0 + i) * 4096]; si[i] = sloc[base + (size_t)(c0 + i) * 4096 + 64]; }
#pragma unroll
    for (int i = 0; i < 16; i++) {
      const size_t o = base + (size_t)(c0 + i) * 4096;
      hin[o] = f2bf(hr); hin[o + 64] = f2bf(hi);
      const float nr = mr * hr - mi * hi + sr[i], ni = mr * hi + mi * hr + si[i];
      hr = nr; hi = ni;
    }
  }
}

#define AK_ST 264
#define AV_ST 40
__device__ __forceinline__ void attn_job(const P& p, int job, u16* sm) {
  const int qt = job & 63, h = (job >> 6) & 3, b = job >> 8;
  const int tid = ltid(), lane = tid & 63, wave = tid >> 6;
  const int tok = b * SEQL + qt * 64 + wave * 16 + (lane & 15);
  u16* Ks = sm;
  u16* Vs = sm + 32 * AK_ST;
  const u16* qp = p.B + (size_t)tok * 1024 + h * 256 + (lane >> 4) * 8;
  bf16x8 qf[8];
#pragma unroll
  for (int kb = 0; kb < 8; kb++) qf[kb] = *(const bf16x8*)(qp + kb * 32);
  f32x4 O[16];
#pragma unroll
  for (int i = 0; i < 16; i++) O[i] = (f32x4){0.f, 0.f, 0.f, 0.f};
  float mrun = -1e30f, lrun = 0.f;
  const int krow = tid >> 5, kch = (tid & 31) * 8;
  const int vrow = tid >> 2, vch = (tid & 3) * 8;
  const u16* kg = p.Kp + (size_t)(b * 256 + krow) * 1024 + h * 256 + kch;
  const u16* vg = p.Vt + ((size_t)((b * 4 + h) * 256 + vrow)) * 256 + vch;
  bf16x8 rk[4], rv[4];
#pragma unroll
  for (int i = 0; i < 4; i++) { rk[i] = *(const bf16x8*)(kg + (size_t)(8 * i) * 1024); rv[i] = *(const bf16x8*)(vg + (size_t)(64 * i) * 256); }
#pragma unroll 1
  for (int nb2 = 0; nb2 < 8; nb2++) {
    __syncthreads();
#pragma unroll
    for (int i = 0; i < 4; i++) {
      *(bf16x8*)(Ks + (krow + 8 * i) * AK_ST + kch) = rk[i];
      *(bf16x8*)(Vs + (vrow + 64 * i) * AV_ST + vch) = rv[i];
    }
    __syncthreads();
    if (nb2 + 1 < 8) {
#pragma unroll
      for (int i = 0; i < 4; i++) {
        rk[i] = *(const bf16x8*)(kg + (size_t)((nb2 + 1) * 32 + 8 * i) * 1024);
        rv[i] = *(const bf16x8*)(vg + (size_t)(64 * i) * 256 + (nb2 + 1) * 32);
      }
    }
    f32x4 S0 = (f32x4){0.f, 0.f, 0.f, 0.f}, S1 = (f32x4){0.f, 0.f, 0.f, 0.f};
    const u16* kr = Ks + (lane & 15) * AK_ST + (lane >> 4) * 8;
#pragma unroll
    for (int kb = 0; kb < 8; kb++) {
      const bf16x8 k0 = *(const bf16x8*)(kr + kb * 32);
      const bf16x8 k1 = *(const bf16x8*)(kr + 16 * AK_ST + kb * 32);
      S0 = MFMA16(k0, qf[kb], S0);
      S1 = MFMA16(k1, qf[kb], S1);
    }
    float mx = fmaxf(fmaxf(fmaxf(S0[0], S0[1]), fmaxf(S0[2], S0[3])), fmaxf(fmaxf(S1[0], S1[1]), fmaxf(S1[2], S1[3])));
    mx = xmax32(xmax16(mx));
    const float mnew = fmaxf(mrun, mx);
    const float alpha = __expf((mrun - mnew) * 0.0625f);
    mrun = mnew;
    float e[8];
#pragma unroll
    for (int r = 0; r < 4; r++) { e[r] = __expf((S0[r] - mnew) * 0.0625f); e[4 + r] = __expf((S1[r] - mnew) * 0.0625f); }
    float ps = (e[0] + e[1]) + (e[2] + e[3]) + (e[4] + e[5]) + (e[6] + e[7]);
    ps = xadd32(xadd16(ps));
    lrun = lrun * alpha + ps;
    const bf16x8 pf = pack8(e);
    const u16* vr = Vs + (lane & 15) * AV_ST + (lane >> 4) * 4;
#pragma unroll
    for (int dt = 0; dt < 16; dt++) {
      union { bf16x8 v; uint2 hh[2]; } va;
      va.hh[0] = *(const uint2*)(vr + dt * 16 * AV_ST);
      va.hh[1] = *(const uint2*)(vr + dt * 16 * AV_ST + 16);
      f32x4 o = O[dt];
      o[0] *= alpha; o[1] *= alpha; o[2] *= alpha; o[3] *= alpha;
      O[dt] = MFMA16(va.v, pf, o);
    }
  }
  const float inv = 1.f / lrun;
  u16* op = p.A + (size_t)tok * 1024 + h * 256 + (lane >> 4) * 4;
#pragma unroll
  for (int dt = 0; dt < 16; dt++) *(uint2*)(op + dt * 16) = pack4(O[dt][0] * inv, O[dt][1] * inv, O[dt][2] * inv, O[dt][3] * inv);
}

#define PROJ1_LD 2816
#define RW_TC 16
struct RwBuf { float dec[RW_TC][64], kk[RW_TC][64], kka[RW_TC][64], kp[RW_TC][64], wr[RW_TC][64], v[RW_TC][16], c[RW_TC][2]; };
__device__ __forceinline__ void rwkv_scan_job(const P& p, int job, char* smc) {
  const u16* proj = (const u16*)p.H;
  const u16* ldb = (const u16*)(p.H + (size_t)T_TOK * PROJ1_LD * 2);
  const u16* ab = ldb + (size_t)T_TOK * 512;
  const int rq = job & 3, h = (job >> 2) & 7, b = job >> 5;
  RwBuf* bufs = (RwBuf*)smc;
  float* ybuf = (float*)(smc + 2 * sizeof(RwBuf));
  const int tid = ltid(), lane = tid & 63, wave = tid >> 6;
  const int jg = tid & 15, tl = tid >> 4;
  const int col = h * 64 + jg * 4;
  float mur[4], muk[4], muv[4], kkc[4], kac[4], rkc[4];
#pragma unroll
  for (int i = 0; i < 4; i++) {
    mur[i] = p.mu[col + i]; muk[i] = p.mu[576 + col + i]; muv[i] = p.mu[1088 + col + i];
    kkc[i] = p.k_k[col + i]; kac[i] = p.k_a[col + i]; rkc[i] = p.r_k[col + i];
  }
  uint2 g_r, g_rp, g_k, g_kp, g_v, g_vp, g_ld, g_a;
  size_t g_t = 0;
  bool g_first = false;
  auto gload = [&](int c) {
    const int l = c * RW_TC + tl;
    const size_t t = (size_t)b * SEQL + l;
    const u16* pr = proj + t * PROJ1_LD + col;
    g_r = *(const uint2*)pr; g_k = *(const uint2*)(pr + 576); g_v = *(const uint2*)(pr + 1088);
    const u16* pp = pr - ((l > 0) ? PROJ1_LD : 0);
    g_rp = *(const uint2*)pp; g_kp = *(const uint2*)(pp + 576); g_vp = *(const uint2*)(pp + 1088);
    g_first = (l == 0);
    g_ld = *(const uint2*)(ldb + t * 512 + col);
    g_a = *(const uint2*)(ab + t * 512 + col);
    g_t = t;
  };
  auto stage = [&](RwBuf& bf) {
    float r[4], rp[4], k[4], kpv[4], v[4], vp[4], ld[4], a[4];
    unpack4(g_r, r); unpack4(g_rp, rp); unpack4(g_k, k); unpack4(g_kp, kpv); unpack4(g_v, v); unpack4(g_vp, vp);
    if (g_first) {
#pragma unroll
      for (int i = 0; i < 4; i++) { rp[i] = 0.f; kpv[i] = 0.f; vp[i] = 0.f; }
    }
    unpack4(g_ld, ld); unpack4(g_a, a);
    float kkr[4], kpr[4], rs[4], vs[4], ss = 0.f;
#pragma unroll
    for (int i = 0; i < 4; i++) {
      rs[i] = r[i] + (rp[i] - r[i]) * mur[i];
      float ks = k[i] + (kpv[i] - k[i]) * muk[i];
      vs[i] = v[i] + (vp[i] - v[i]) * muv[i];
      kkr[i] = ks * kkc[i];
      ss += kkr[i] * kkr[i];
      kpr[i] = ks * (1.f + (a[i] - 1.f) * kac[i]);
    }
    ss = sum16(ss);
    const float inv = rsqrtf(fmaxf(ss, 1e-24f));
    float c1 = 0.f, c2 = 0.f, c3 = 0.f;
    float dk[4], kk4[4], kka4[4], wr4[4];
#pragma unroll
    for (int i = 0; i < 4; i++) {
      kk4[i] = kkr[i] * inv;
      kka4[i] = kk4[i] * a[i];
      dk[i] = __expf(ld[i]);
      wr4[i] = dk[i] * rs[i];
      c1 += kka4[i] * rs[i];
      c2 += kpr[i] * rs[i];
      c3 += kpr[i] * rs[i] * rkc[i];
    }
    c1 = sum16(c1); c2 = sum16(c2); c3 = sum16(c3);
    *(float4*)&bf.dec[tl][jg * 4] = make_float4(dk[0], dk[1], dk[2], dk[3]);
    *(float4*)&bf.kk[tl][jg * 4] = make_float4(kk4[0], kk4[1], kk4[2], kk4[3]);
    *(float4*)&bf.kka[tl][jg * 4] = make_float4(kka4[0], kka4[1], kka4[2], kka4[3]);
    *(float4*)&bf.kp[tl][jg * 4] = make_float4(kpr[0], kpr[1], kpr[2], kpr[3]);
    *(float4*)&bf.wr[tl][jg * 4] = make_float4(wr4[0], wr4[1], wr4[2], wr4[3]);
    if ((jg >> 2) == rq) *(float4*)&bf.v[tl][(jg & 3) * 4] = make_float4(vs[0], vs[1], vs[2], vs[3]);
    if (jg == 0) { bf.c[tl][0] = c1; bf.c[tl][1] = c2; if (rq == 0) p.c3buf[(size_t)g_t * 8 + h] = c3; }
  };
  __syncthreads();
  gload(0);
  stage(bufs[0]);
  __syncthreads();
  typedef float v2f __attribute__((ext_vector_type(2)));
  v2f Sa = {0.f, 0.f}, Sb = {0.f, 0.f};
  const int il = wave * 4 + (lane >> 4);
  const float m0 = ((lane & 15) == 0) ? 1.f : 0.f;
  const bool b3 = lane & 8, b2 = lane & 4, b1 = lane & 2, b0 = lane & 1;
  const int NCH = SEQL / RW_TC;
  for (int c = 0; c < NCH; c++) {
    const bool more = (c + 1) < NCH;
    if (more) gload(c + 1);
    const RwBuf& bf = bufs[c & 1];
    float* yb = ybuf + (c & 1) * 256;
    float yv[RW_TC];
    float4 o_dec[3], o_kk[3], o_kka[3], o_kp[3], o_wr[3];
    float o_vi[3];
    float2 o_c[3];
#define RW_LD(slot, tt)                                                                          \
    { o_dec[slot] = *(const float4*)&bf.dec[tt][jg * 4]; o_kk[slot] = *(const float4*)&bf.kk[tt][jg * 4];   \
      o_kka[slot] = *(const float4*)&bf.kka[tt][jg * 4]; o_kp[slot] = *(const float4*)&bf.kp[tt][jg * 4];   \
      o_wr[slot] = *(const float4*)&bf.wr[tt][jg * 4]; o_vi[slot] = bf.v[tt][il]; o_c[slot] = *(const float2*)&bf.c[tt][0]; }
    RW_LD(0, 0);
    RW_LD(1, 1);
#pragma unroll
    for (int t = 0; t < RW_TC; t++) {
      if (t + 2 < RW_TC) RW_LD((t + 2) % 3, t + 2);
      const float4 dec = o_dec[t % 3], kk = o_kk[t % 3], kka = o_kka[t % 3], kp = o_kp[t % 3], wr = o_wr[t % 3];
      const float vi = o_vi[t % 3], c1 = o_c[t % 3].x, c2 = o_c[t % 3].y;
      const v2f kk0 = {kk.x, kk.y}, kk1 = {kk.z, kk.w}, wr0 = {wr.x, wr.y}, wr1 = {wr.z, wr.w};
      v2f ps = Sa * kk0 + Sb * kk1;
      v2f py = Sa * wr0 + Sb * wr1;
      float sa = ps.x + ps.y, yd = py.x + py.y;
      sa = sum16(sa);
      yv[t] = yd + m0 * (vi * c2 - sa * c1);
      const v2f dec0 = {dec.x, dec.y}, dec1 = {dec.z, dec.w}, ka0 = {kka.x, kka.y}, ka1 = {kka.z, kka.w},
                kp0 = {kp.x, kp.y}, kp1 = {kp.z, kp.w};
      const v2f sav = {sa, sa}, viv = {vi, vi};
      Sa = Sa * dec0 - sav * ka0 + viv * kp0;
      Sb = Sb * dec1 - sav * ka1 + viv * kp1;
    }
#undef RW_LD
    {
      float r8[8], r4[4], r2[2];
#pragma unroll
      for (int i = 0; i < 8; i++) {
        const float keep = b3 ? yv[i + 8] : yv[i], send = b3 ? yv[i] : yv[i + 8];
        r8[i] = keep + dppf<0x128>(send);
      }
#pragma unroll
      for (int i = 0; i < 4; i++) {
        const float keep = b2 ? r8[i + 4] : r8[i], send = b2 ? r8[i] : r8[i + 4];
        r4[i] = keep + dppf<0x141>(send);
      }
#pragma unroll
      for (int i = 0; i < 2; i++) {
        const float keep = b1 ? r4[i + 2] : r4[i], send = b1 ? r4[i] : r4[i + 2];
        r2[i] = keep + dppf<0x4E>(send);
      }
      const float keep = b0 ? r2[1] : r2[0], send = b0 ? r2[0] : r2[1];
      const float ysum = keep + dppf<0xB1>(send);
      yb[(lane & 15) * 16 + il] = ysum;
    }
    if (more) stage(bufs[(c + 1) & 1]);
    __syncthreads();
    {
      const int tt = tid >> 4, ii = tid & 15;
      const size_t t = (size_t)b * SEQL + c * RW_TC + tt;
      p.A[t * 1024 + h * 64 + rq * 16 + ii] = f2bf(yb[tt * 16 + ii]);
    }
  }
}

#define LRU_LB 16
__device__ __forceinline__ void lru_scan_job(const P& p, int job, float* sm) {
  const u16* proj = (const u16*)p.H;
  const u16* lab = p.B;
  const u16* bbuf = p.B + (size_t)T_TOK * 512;
  const int lane = ltid() & 63, seg = ltid() >> 6;
  const int b = job >> 3, ch = (job & 7) * 64 + lane;
  const size_t tb = (size_t)b * SEQL + seg * 1024;
  float* segP = sm;
  float* segH = sm + 256;
  __syncthreads();
  float P_ = 1.f, hl = 0.f;
  {
    u16 la_n[LRU_LB], b_n[LRU_LB];
#pragma unroll
    for (int i = 0; i < LRU_LB; i++) { la_n[i] = lab[(tb + i) * 512 + ch]; b_n[i] = bbuf[(tb + i) * 512 + ch]; }
    for (int l0 = 0; l0 < 1024; l0 += LRU_LB) {
      u16 la_c[LRU_LB], b_c[LRU_LB];
#pragma unroll
      for (int i = 0; i < LRU_LB; i++) { la_c[i] = la_n[i]; b_c[i] = b_n[i]; }
      if (l0 + LRU_LB < 1024) {
#pragma unroll
        for (int i = 0; i < LRU_LB; i++) { la_n[i] = lab[(tb + l0 + LRU_LB + i) * 512 + ch]; b_n[i] = bbuf[(tb + l0 + LRU_LB + i) * 512 + ch]; }
      }
#pragma unroll
      for (int i = 0; i < LRU_LB; i++) {
        const float a = __expf(bf2f(la_c[i]));
        hl = a * hl + bf2f(b_c[i]);
        P_ *= a;
      }
    }
  }
  segP[seg * 64 + lane] = P_;
  segH[seg * 64 + lane] = hl;
  __syncthreads();
  float hs = 0.f;
  for (int s2 = 0; s2 < seg; s2++) hs = segP[s2 * 64 + lane] * hs + segH[s2 * 64 + lane];
  {
    u16 la_n[LRU_LB], b_n[LRU_LB], g_n[LRU_LB];
#pragma unroll
    for (int i = 0; i < LRU_LB; i++) {
      la_n[i] = lab[(tb + i) * 512 + ch]; b_n[i] = bbuf[(tb + i) * 512 + ch]; g_n[i] = proj[(tb + i) * PROJ1_LD + 2304 + ch];
    }
    for (int l0 = 0; l0 < 1024; l0 += LRU_LB) {
      u16 la_c[LRU_LB], b_c[LRU_LB], g_c[LRU_LB];
#pragma unroll
      for (int i = 0; i < LRU_LB; i++) { la_c[i] = la_n[i]; b_c[i] = b_n[i]; g_c[i] = g_n[i]; }
      if (l0 + LRU_LB < 1024) {
#pragma unroll
        for (int i = 0; i < LRU_LB; i++) {
          const size_t t = tb + l0 + LRU_LB + i;
          la_n[i] = lab[t * 512 + ch]; b_n[i] = bbuf[t * 512 + ch]; g_n[i] = proj[t * PROJ1_LD + 2304 + ch];
        }
      }
#pragma unroll
      for (int i = 0; i < LRU_LB; i++) {
        const float a = __expf(bf2f(la_c[i]));
        hs = a * hs + bf2f(b_c[i]);
        const float g = bf2f(g_c[i]);
        const float u2 = 1.5957691216057308f * (g + 0.044715f * g * g * g);
        const float ge = g * frcp(1.f + __expf(-u2));
        p.A[(tb + l0 + i) * 1024 + 512 + ch] = f2bf(hs * ge);
      }
    }
  }
}

__device__ __forceinline__ void rw_shift8(const u16* proj, const float* mu, int m, int col, float* f) {
  const u16* pr = proj + (size_t)m * PROJ1_LD + col;
  float a[8], b[8];
  unpack8(*(const uint4*)pr, a);
  const bool hasprev = (m & (SEQL - 1)) != 0;
  unpack8(*(const uint4*)(pr - (hasprev ? PROJ1_LD : 0)), b);
  const float pz = hasprev ? 1.f : 0.f;
#pragma unroll
  for (int i = 0; i < 8; i++) b[i] *= pz;
  float4 m0 = *(const float4*)(mu + col), m1 = *(const float4*)(mu + col + 4);
  float mm[8] = {m0.x, m0.y, m0.z, m0.w, m1.x, m1.y, m1.z, m1.w};
#pragma unroll
  for (int i = 0; i < 8; i++) f[i] = a[i] + (b[i] - a[i]) * mm[i];
}
__device__ __forceinline__ void rw_shift4(const u16* proj, const float* mu, int m, int col, float* f) {
  const u16* pr = proj + (size_t)m * PROJ1_LD + col;
  float a[4], b[4];
  unpack4(*(const uint2*)pr, a);
  const bool hasprev = (m & (SEQL - 1)) != 0;
  unpack4(*(const uint2*)(pr - (hasprev ? PROJ1_LD : 0)), b);
  const float pz = hasprev ? 1.f : 0.f;
  b[0] *= pz; b[1] *= pz; b[2] *= pz; b[3] *= pz;
  float4 m0 = *(const float4*)(mu + col);
  f[0] = a[0] + (b[0] - a[0]) * m0.x; f[1] = a[1] + (b[1] - a[1]) * m0.y;
  f[2] = a[2] + (b[2] - a[2]) * m0.z; f[3] = a[3] + (b[3] - a[3]) * m0.w;
}

struct AL5 {
  const u16* pj; int g;
  __device__ __forceinline__ bf16x8 operator()(int m, int k, int) const {
    return *(const bf16x8*)(pj + (size_t)(m * 16 + (k >> 4)) * PROJ0_LD + 1552 + g * 16 + (k & 15));
  }
};
struct ALw { const u16* pj; const float* mu;
  __device__ __forceinline__ bf16x8 operator()(int m, int k, int) const {
    float f[8]; rw_shift8(pj, mu, m, 512 + k, f);
#pragma unroll
    for (int i = 0; i < 8; i++) f[i] = fast_tanh(f[i]);
    return pack8(f); } };
struct ALa { const u16* pj; const float* mu;
  __device__ __forceinline__ bf16x8 operator()(int m, int k, int) const {
    float f[8]; rw_shift8(pj, mu, m, 1600 + k, f); return pack8(f); } };
struct ALg { const u16* pj; const float* mu;
  __device__ __forceinline__ bf16x8 operator()(int m, int k, int) const {
    float f[8]; rw_shift8(pj, mu, m, 1664 + k, f);
#pragma unroll
    for (int i = 0; i < 8; i++) f[i] = sigmoidf_(f[i]);
    return pack8(f); } };
struct ALl { const u16* pj; const float* cw; const float* cb;
  __device__ __forceinline__ bf16x8 operator()(int m, int k, int nt) const {
    const int ch = nt * 64 + k;
    float acc[8];
    float4 b0 = *(const float4*)(cb + ch), b1 = *(const float4*)(cb + ch + 4);
    acc[0] = b0.x; acc[1] = b0.y; acc[2] = b0.z; acc[3] = b0.w; acc[4] = b1.x; acc[5] = b1.y; acc[6] = b1.z; acc[7] = b1.w;
    const int l = m & (SEQL - 1);
#pragma unroll
    for (int j = 0; j < 4; j++) {
      {
        const bool ok = (l - 3 + j) >= 0;
        const float z = ok ? 1.f : 0.f;
        float x[8];
        unpack8(*(const uint4*)(pj + (size_t)(m - (ok ? 3 - j : 0)) * PROJ1_LD + 1792 + ch), x);
        float4 w0 = *(const float4*)(cw + j * 512 + ch), w1 = *(const float4*)(cw + j * 512 + ch + 4);
        acc[0] += z * w0.x * x[0]; acc[1] += z * w0.y * x[1]; acc[2] += z * w0.z * x[2]; acc[3] += z * w0.w * x[3];
        acc[4] += z * w1.x * x[4]; acc[5] += z * w1.y * x[5]; acc[6] += z * w1.z * x[6]; acc[7] += z * w1.w * x[7];
      }
    }
    return pack8(acc); } };
struct EPlru {
  const u16* pj; u16* lab; u16* bb; const float* cw; const float* cb; const float* lb_a; const float* lb_x; const float* llam;
  __device__ __forceinline__ void operator()(f32x4 (&acc)[4][4], int mw, int nw, int lane, int nt) const {
    const int wn = (nw >> 6) & 1;
    uint2 xr[2][4][4];
#pragma unroll
    for (int q = 0; q < 2; q++) {
      const int ch = nt * 64 + wn * 32 + q * 16 + (lane >> 4) * 4;
#pragma unroll
      for (int j = 0; j < 4; j++) {
        const int m = mw + j * 16 + (lane & 15);
        const int l = m & (SEQL - 1);
#pragma unroll
        for (int d = 0; d < 4; d++)
          xr[q][j][d] = *(const uint2*)(pj + (size_t)(m - (l >= d ? d : 0)) * PROJ1_LD + 1792 + ch);
      }
    }
#pragma unroll
    for (int q = 0; q < 2; q++) {
      const int ch = nt * 64 + wn * 32 + q * 16 + (lane >> 4) * 4;
      const float4 ba = *(const float4*)(lb_a + ch), bx = *(const float4*)(lb_x + ch), lm = *(const float4*)(llam + ch);
      const float4 cbv = *(const float4*)(cb + ch);
      const float4 w0 = *(const float4*)(cw + ch), w1 = *(const float4*)(cw + 512 + ch), w2 = *(const float4*)(cw + 1024 + ch),
                   w3 = *(const float4*)(cw + 1536 + ch);
      const float sp[4] = {softplusf_(-lm.x), softplusf_(-lm.y), softplusf_(-lm.z), softplusf_(-lm.w)};
      const float bav[4] = {ba.x, ba.y, ba.z, ba.w}, bxv[4] = {bx.x, bx.y, bx.z, bx.w};
      const float wd[4][4] = {{w3.x, w3.y, w3.z, w3.w}, {w2.x, w2.y, w2.z, w2.w}, {w1.x, w1.y, w1.z, w1.w}, {w0.x, w0.y, w0.z, w0.w}};
#pragma unroll
      for (int j = 0; j < 4; j++) {
        const int m = mw + j * 16 + (lane & 15);
        const int l = m & (SEQL - 1);
        float xc[4] = {cbv.x, cbv.y, cbv.z, cbv.w};
#pragma unroll
        for (int d = 0; d < 4; d++) {
          float x[4];
          unpack4(xr[q][j][d], x);
          const float z = (l >= d) ? 1.f : 0.f;
          xc[0] += z * wd[d][0] * x[0]; xc[1] += z * wd[d][1] * x[1]; xc[2] += z * wd[d][2] * x[2]; xc[3] += z * wd[d][3] * x[3];
        }
        float la[4], bo[4];
#pragma unroll
        for (int r = 0; r < 4; r++) {
          const float rg = sigmoidf_(acc[2 * q][j][r] + bav[r]);
          const float ig = sigmoidf_(acc[2 * q + 1][j][r] + bxv[r]);
          la[r] = -8.f * rg * sp[r];
          const float mult = __builtin_amdgcn_sqrtf(fmaxf(1.f - __expf(2.f * la[r]), 0.f));
          bo[r] = mult * ig * xc[r];
        }
        *(uint2*)(lab + (size_t)m * 512 + ch) = pack4(la[0], la[1], la[2], la[3]);
        *(uint2*)(bb + (size_t)m * 512 + ch) = pack4(bo[0], bo[1], bo[2], bo[3]);
      }
    }
  }
};
struct EPfin {
  const u16* pj; const float* mu; u16* A; const float* c3buf; const float* ln_g; const float* ln_b;
  __device__ __forceinline__ void operator()(f32x4 (&acc)[4][4], int mw, int nw, int lane, int) const {
    const int hh = nw >> 6;
#pragma unroll
    for (int j = 0; j < 4; j++) {
      const int m = mw + j * 16 + (lane & 15);
      float y[16], sum = 0.f;
      const float c3 = c3buf[(size_t)m * 8 + hh];
#pragma unroll
      for (int i = 0; i < 4; i++) {
        const int ch = nw + i * 16 + (lane >> 4) * 4;
        unpack4(*(const uint2*)(A + (size_t)m * 1024 + ch), y + i * 4);
        sum += y[i * 4] + y[i * 4 + 1] + y[i * 4 + 2] + y[i * 4 + 3];
      }
      sum = xadd32(xadd16(sum));
      const float mean = sum * (1.f / 64.f);
      float var = 0.f;
#pragma unroll
      for (int i = 0; i < 16; i++) var += (y[i] - mean) * (y[i] - mean);
      var = xadd32(xadd16(var));
      const float rstd = rsqrtf(var * (1.f / 64.f) + 64e-5f);
#pragma unroll
      for (int i = 0; i < 4; i++) {
        const int ch = nw + i * 16 + (lane >> 4) * 4;
        float vs[4];
        rw_shift4(pj, mu, m, 1088 + ch, vs);
        float4 lg = *(const float4*)(ln_g + ch), lb = *(const float4*)(ln_b + ch);
        float o0 = ((y[i * 4 + 0] - mean) * rstd * lg.x + lb.x + c3 * vs[0]) * acc[i][j][0];
        float o1 = ((y[i * 4 + 1] - mean) * rstd * lg.y + lb.y + c3 * vs[1]) * acc[i][j][1];
        float o2 = ((y[i * 4 + 2] - mean) * rstd * lg.z + lb.z + c3 * vs[2]) * acc[i][j][2];
        float o3 = ((y[i * 4 + 3] - mean) * rstd * lg.w + lb.w + c3 * vs[3]) * acc[i][j][3];
        *(uint2*)(A + (size_t)m * 1024 + ch) = pack4(o0, o1, o2, o3);
      }
    }
  }
};

#define XB_TMO      128
#define XB_XCNT(j)  (256  + 64 * (j))
#define XB_XSUB(j)  (1280 + 64 * (j))
#define XB_XGEN(j)  (2304 + 64 * (j))
#define XB_TOP      3328
#define XB_TOPGEN   3392
#define XCD_BAR_WORDS 3456
#define XB_SPIN_CAP (1u << 22)
#define LAS __attribute__((address_space(3)))
__device__ __forceinline__ unsigned xb_ld(unsigned* p)              { return __hip_atomic_load(p, __ATOMIC_RELAXED, __HIP_MEMORY_SCOPE_AGENT); }
__device__ __forceinline__ unsigned xb_add(unsigned* p, unsigned v) { return __hip_atomic_fetch_add(p, v, __ATOMIC_RELAXED, __HIP_MEMORY_SCOPE_AGENT); }
__device__ __forceinline__ unsigned xb_xcc_id() { return (unsigned)__builtin_amdgcn_s_getreg((3 << 11) | 20) & 0xFu; }
#define XB_SPIN(cond, bar) do { unsigned _sp = 0; while (cond) { __builtin_amdgcn_s_sleep(1); \
    if ((++_sp & 255u) == 0u) { if (xb_ld(&(bar)[XB_TMO])) break; if (_sp > XB_SPIN_CAP) { atomicAdd(&(bar)[XB_TMO], 1u); break; } } } } while (0)
struct XcdBarrier { unsigned* bar; unsigned x; volatile LAS unsigned* st; };
__device__ __forceinline__ XcdBarrier xcd_barrier_post(unsigned* bar, volatile LAS unsigned* st) {
  XcdBarrier b; b.bar = bar; b.x = xb_xcc_id(); b.st = st;
  if (threadIdx.x == 0) (void)xb_add(&bar[XB_XCNT(b.x)], 1u);
  return b;
}
__device__ __forceinline__ void xcd_barrier_complete(unsigned* bar, unsigned x, unsigned& nloc, unsigned& nx) {
  const unsigned G = gridDim.x * gridDim.y * gridDim.z;
  unsigned sum, cnt, mine, sp = 0u;
  for (;;) {
    sum = 0u; cnt = 0u; mine = 0u;
#pragma unroll
    for (unsigned j = 0; j < 16; ++j) { const unsigned c = xb_ld(&bar[XB_XCNT(j)]); sum += c; cnt += (c > 0u) ? 1u : 0u; mine = (j == x) ? c : mine; }
    if (sum == G) break;
    __builtin_amdgcn_s_sleep(1);
    if ((++sp & 255u) == 0u) { if (xb_ld(&bar[XB_TMO])) break; if (sp > XB_SPIN_CAP) { atomicAdd(&bar[XB_TMO], 1u); break; } }
  }
  nloc = mine > 0u ? mine : 1u; nx = cnt > 0u ? cnt : 1u;
}
__device__ __forceinline__ void xcd_barrier(const XcdBarrier& b) {
  asm volatile("s_waitcnt vmcnt(0)" ::: "memory");
  __syncthreads();
  if (threadIdx.x == 0) {
    unsigned* bar = b.bar;
    __builtin_amdgcn_s_waitcnt(0);
    unsigned nloc = b.st[0], nx = b.st[1];
    if (nloc == 0u) { xcd_barrier_complete(bar, b.x, nloc, nx); b.st[0] = nloc; b.st[1] = nx; }
    const unsigned old = xb_add(&bar[XB_XSUB(b.x)], 1u);
    const unsigned gen = old / nloc;
    if (old + 1u == (gen + 1u) * nloc) {
      __builtin_amdgcn_fence(__ATOMIC_RELEASE, "agent");
      asm volatile("s_waitcnt vmcnt(0)" ::: "memory");
      const unsigned og = xb_add(&bar[XB_TOP], 1u);
      const unsigned tg = og / nx;
      if (og + 1u == (tg + 1u) * nx) xb_add(&bar[XB_TOPGEN], 1u);
      else XB_SPIN(xb_ld(&bar[XB_TOPGEN]) == tg, bar);
      __builtin_amdgcn_fence(__ATOMIC_ACQUIRE, "agent");
      xb_add(&bar[XB_XGEN(b.x)], 1u);
      asm volatile("s_waitcnt vmcnt(0)" ::: "memory");
    } else {
      XB_SPIN(xb_ld(&bar[XB_XGEN(b.x)]) == gen, bar);
      __builtin_amdgcn_fence(__ATOMIC_ACQUIRE, "agent");
      asm volatile("s_waitcnt vmcnt(0)" ::: "memory");
    }
  }
  __syncthreads();
}

__device__ __forceinline__ void kv_tile(const P& p, int t, u16* smu) {
  auto fk = [=] __device__(int m, int n, const f32x4& a, int) {
    *(uint2*)(p.Kp + (size_t)m * 1024 + n) = pack4(a[0], a[1], a[2], a[3]);
  };
  auto fv = [=] __device__(int m, int n, const f32x4& a, int) {
    const int bb = m >> 8, mm = m & 255, hh = n >> 8, d = n & 255;
    u16* vp = p.Vt + ((size_t)((bb * 4 + hh) * 256 + d)) * 256 + mm;
    vp[0] = f2bf(a[0]); vp[256] = f2bf(a[1]); vp[512] = f2bf(a[2]); vp[768] = f2bf(a[3]);
  };
  if (t < 64) gemm_tile(ALbf{p.memn, 1024}, p.Wk, 1024, (t & 7) * 128, (t >> 3) * 128, 0, EPgen<decltype(fk)>{fk}, smu);
  else gemm_tile(ALbf{p.memn, 1024}, p.Wv, 1024, (t & 7) * 128, ((t - 64) >> 3) * 128, 0, EPgen<decltype(fv)>{fv}, smu);
}

__global__ void __launch_bounds__(NTHR, 2) mega(P p, int ph_lo, int ph_hi) {
  cg::grid_group grid = cg::this_grid();
  __shared__ __attribute__((aligned(1024))) char smem[73728];
  __shared__ uint4 xb_words;
  if (threadIdx.x == 0) xb_words = make_uint4(0u, 0u, 0u, 0u);
  __syncthreads();
  XcdBarrier xb; xb.bar = p.bar; xb.x = 0; xb.st = (volatile LAS unsigned*)&xb_words;
  if (blockIdx.x == 0) { for (int i = threadIdx.x; i < XCD_BAR_WORDS; i += NTHR) p.bar[i] = 0u; }
  const int nb = gridDim.x, nw = nb * 4;
  u16* smu = (u16*)smem;
  const u16* proj = (const u16*)p.H;

  for (int si = ph_lo; si < ph_hi; ++si) {
    const int ph = p.seq[si];
    if (si > ph_lo) { if (si == ph_lo + 1) { grid.sync(); xb = xcd_barrier_post(p.bar, (volatile LAS unsigned*)&xb_words); } else xcd_barrier(xb); }
    int bid = blockIdx.x;
    asm volatile("" : "+s"(bid));
    const int tid = ltid();
    const int gw = bid * 4 + (tid >> 6);
    const int layer = ph >= 15 ? 1 : 0;
    const float* ng = p.norm_gain + layer * 7 * 1024;
    switch (ph) {
      case 0: {
        if (bid < 32) s5_precompute(p, bid, (float*)smem);
        else if (bid < 40) lru_weight_job(p, bid - 32);
        if (bid >= 32) transpose_jobs(p.tab0, p.ntab0, p.ntiles0, (float*)smem, bid - 32, nb - 32);
        norm_rows(p.mem, p.norm_gain + 6 * 1024, p.memn, 1024, gw, nw);
        norm_rows(p.x, p.norm_gain, p.A, T_TOK, gw, nw);
      } break;
      case 1: {
        auto f = [=] __device__(int m, int n, const f32x4& a, int) {
          if (n < 2064) *(uint2*)((u16*)p.H + (size_t)m * PROJ0_LD + n) = pack4(a[0], a[1], a[2], a[3]);
        };
        auto f8 = [=] __device__(int m, int n, const f32x4& a, const f32x4& b) {
          *(uint4*)((u16*)p.H + (size_t)m * PROJ0_LD + n) = pack8v(a, b);
        };
        gemm_big_jobs(ALbf{p.A, 1024}, p.Win0, 1024, 16, f8, smu, bid, nb);
        __syncthreads();
        for (int t = bid; t < 128; t += nb) gemm_tile(ALbf{p.A, 1024}, p.Win0, 1024, t * 128, 16 * 128, 16, EPgen<decltype(f)>{f}, smu);
      } break;
      case 2: {
        for (int j = bid; j < 1024; j += nb) gla_state_job(p, j, smem);
        __syncthreads();
        float* ybuf = (float*)(p.H + (size_t)T_TOK * PROJ0_LD * 2 + (size_t)32 * 1024 * 1024);
        float* sloc = (float*)p.B;
        for (int t = bid; t < 32 * 8 * 3; t += nb) {
          const int g = t / 24, r = t % 24, mt = r & 7, ntl = r >> 3;
          auto f = [=] __device__(int m, int n, const f32x4& a, int) {
            if (n < 256) *(float4*)(ybuf + (size_t)(m * 16 + (n >> 4)) * 512 + g * 16 + (n & 15)) = make_float4(a[0], a[1], a[2], a[3]);
            else *(float4*)(sloc + ((size_t)(m * 32 + g)) * 128 + (n - 256)) = make_float4(a[0], a[1], a[2], a[3]);
          };
          gemm_tile(AL5{proj, g}, p.S5W1 + (size_t)g * 384 * 256, 256, mt * 128, ntl * 128, ntl, EPgen<decltype(f)>{f}, smu);
        }
      } break;
      case 3: {
        for (int j = bid; j < 512; j += nb) gla_scan_job(p, j);
        for (int t = bid; t < 256; t += nb) {
          __syncthreads();
          if (t < 128) s5_scan_job(p, t, (float*)smem); else kv_tile(p, t - 128, smu);
        }
      } break;
      case 4: {
        for (int j = bid; j < 1024; j += nb) gla_out_job(p, j, smem);
        __syncthreads();
        float* ybuf = (float*)(p.H + (size_t)T_TOK * PROJ0_LD * 2 + (size_t)32 * 1024 * 1024);
        const u16* hin = p.B + (size_t)8 * 1024 * 1024;
        for (int t = bid; t < 32 * 8 * 2; t += nb) {
          const int g = t >> 4, r = t & 15, mt = r & 7, ntl = r >> 3;
          auto f = [=] __device__(int m, int n, const f32x4& a, int) {
            const int tok = m * 16 + (n >> 4), ch = g * 16 + (n & 15);
            float* yp = ybuf + (size_t)tok * 512 + ch;
            float4 y0 = *(const float4*)yp;
            float u[4];
            unpack4(*(const uint2*)(proj + (size_t)tok * PROJ0_LD + 1552 + ch), u);
            float4 d = *(const float4*)(p.s5_d + ch);
            *(float4*)yp = make_float4(y0.x + a[0] + d.x * u[0], y0.y + a[1] + d.y * u[1], y0.z + a[2] + d.z * u[2], y0.w + a[3] + d.w * u[3]);
          };
          gemm_tile(ALbf{hin + (size_t)g * 128, 32 * 128}, p.S5W2 + (size_t)g * 256 * 128, 128, mt * 128, ntl * 128, ntl,
                    EPgen<decltype(f)>{f}, smu);
        }
      } break;
      case 5: {
        const float* ybuf = (const float*)(p.H + (size_t)T_TOK * PROJ0_LD * 2 + (size_t)32 * 1024 * 1024);
        auto f = [=] __device__(int m, int n, const f32x4& a, int) {
          float4 y = *(const float4*)(ybuf + (size_t)m * 512 + n);
          float4 bg = *(const float4*)(p.s5_bglu + n);
          *(uint2*)(p.A + (size_t)m * 1024 + 512 + n) =
              pack4(gelu_tanh(y.x) * sigmoidf_(a[0] + bg.x), gelu_tanh(y.y) * sigmoidf_(a[1] + bg.y),
                    gelu_tanh(y.z) * sigmoidf_(a[2] + bg.z), gelu_tanh(y.w) * sigmoidf_(a[3] + bg.w));
        };
        gemm_jobs(ALf32{ybuf, 512}, p.Wglu, 512, 128, 4, EPgen<decltype(f)>{f}, smu, bid, nb);
      } break;
      case 6: case 19: {
        auto f = [=] __device__(int m, int n, const f32x4& a, int) {
          *(uint2*)(p.B + (size_t)m * 1024 + n) = pack4(a[0], a[1], a[2], a[3]);
        };
        auto f8 = [=] __device__(int m, int n, const f32x4& a, const f32x4& b) { *(uint4*)(p.B + (size_t)m * 1024 + n) = pack8v(a, b); };
        gemm_big_jobs(ALbf{p.A, 1024}, ph == 6 ? p.Wout0 : p.Wout1, 1024, 8, f8, smu, bid, nb);
      } break;
      case 7: case 20:
        if (ph == 20 && bid < 128) kv_tile(p, bid, smu);
        resid_norm(ph == 7 ? p.x : p.out, p.B, ng + 1 * 1024, ng + 2 * 1024, p.out, p.A, gw, nw);
        break;
      case 8: case 21: {
        auto f = [=] __device__(int m, int n, const f32x4& a, int) {
          *(uint2*)(p.B + (size_t)m * 1024 + n) = pack4(a[0], a[1], a[2], a[3]);
        };
        auto f8 = [=] __device__(int m, int n, const f32x4& a, const f32x4& b) { *(uint4*)(p.B + (size_t)m * 1024 + n) = pack8v(a, b); };
        gemm_big_jobs(ALbf{p.A, 1024}, p.Wq, 1024, 8, f8, smu, bid, nb);
      } break;
      case 9: case 22:
        for (int j = bid; j < 1024; j += nb) attn_job(p, j, smu);
        break;
      case 10: case 23: {
        auto f = [=] __device__(int m, int n, const f32x4& a, int) {
          *(uint2*)(p.B + (size_t)m * 1024 + n) = pack4(a[0], a[1], a[2], a[3]);
        };
        auto f8 = [=] __device__(int m, int n, const f32x4& a, const f32x4& b) { *(uint4*)(p.B + (size_t)m * 1024 + n) = pack8v(a, b); };
        gemm_big_jobs(ALbf{p.A, 1024}, p.Wo, 1024, 8, f8, smu, bid, nb);
      } break;
      case 11: case 24:
        resid_norm(p.out, p.B, ng + 3 * 1024, ng + 4 * 1024, p.out, p.A, gw, nw);
        break;
      case 12: case 25: {
        u16* hid = (u16*)p.H;
        auto f = [=] __device__(int m, int n, const f32x4& a, int) {
          float r0 = fmaxf(a[0], 0.f), r1 = fmaxf(a[1], 0.f), r2 = fmaxf(a[2], 0.f), r3 = fmaxf(a[3], 0.f);
          *(uint2*)(hid + (size_t)m * 4096 + n) = pack4(r0 * r0, r1 * r1, r2 * r2, r3 * r3);
        };
        auto f8 = [=] __device__(int m, int n, const f32x4& a, const f32x4& b) {
          f32x4 ra, rb;
#pragma unroll
          for (int q = 0; q < 4; q++) { float x = fmaxf(a[q], 0.f), y = fmaxf(b[q], 0.f); ra[q] = x * x; rb[q] = y * y; }
          *(uint4*)(hid + (size_t)m * 4096 + n) = pack8v(ra, rb);
        };
        gemm_big_jobs(ALbf{p.A, 1024}, p.W1, 1024, 32, f8, smu, bid, nb);
      } break;
      case 13: case 26: {
        auto f = [=] __device__(int m, int n, const f32x4& a, int) {
          *(uint2*)(p.B + (size_t)m * 1024 + n) = pack4(a[0], a[1], a[2], a[3]);
        };
        auto f8 = [=] __device__(int m, int n, const f32x4& a, const f32x4& b) { *(uint4*)(p.B + (size_t)m * 1024 + n) = pack8v(a, b); };
        gemm_big_jobs(ALbf{(const u16*)p.H, 4096}, p.W2, 4096, 8, f8, smu, bid, nb);
      } break;
      case 14:
        resid_norm(p.out, p.B, ng + 5 * 1024, p.norm_gain + 7 * 1024, p.out, p.A, gw, nw);
        break;
      case 27:
        resid_norm(p.out, p.B, ng + 5 * 1024, nullptr, p.out, nullptr, gw, nw);
        break;
      case 15: {
        norm_rows(p.mem, p.norm_gain + 13 * 1024, p.memn, 1024, gw, nw);
        auto f = [=] __device__(int m, int n, const f32x4& a, int) {
          *(uint2*)((u16*)p.H + (size_t)m * PROJ1_LD + n) = pack4(a[0], a[1], a[2], a[3]);
        };
        auto f8 = [=] __device__(int m, int n, const f32x4& a, const f32x4& b) { *(uint4*)((u16*)p.H + (size_t)m * PROJ1_LD + n) = pack8v(a, b); };
        gemm_big_jobs(ALbf{p.A, 1024}, p.Win1, 1024, 22, f8, smu, bid, nb);
      } break;
      case 16: {
        u16* ldb = (u16*)(p.H + (size_t)T_TOK * PROJ1_LD * 2);
        u16* ab = ldb + (size_t)T_TOK * 512;
        u16* lab = p.B;
        u16* ib = p.B + (size_t)T_TOK * 512;
        auto fw = [=] __device__(int m, int n, const f32x4& a, int) {
          float4 w0 = *(const float4*)(p.w0 + n);
          float o[4] = {w0.x + a[0], w0.y + a[1], w0.z + a[2], w0.w + a[3]};
#pragma unroll
          for (int i = 0; i < 4; i++) { float wv = -softplusf_(-o[i]) - 0.5f; o[i] = -__expf(wv); }
          *(uint2*)(ldb + (size_t)m * 512 + n) = pack4(o[0], o[1], o[2], o[3]);
        };
        auto fa = [=] __device__(int m, int n, const f32x4& a, int) {
          float4 a0 = *(const float4*)(p.a0 + n);
          *(uint2*)(ab + (size_t)m * 512 + n) = pack4(sigmoidf_(a0.x + a[0]), sigmoidf_(a0.y + a[1]), sigmoidf_(a0.z + a[2]), sigmoidf_(a0.w + a[3]));
        };
        for (int t = bid; t < 512 + 512 + 1024; t += nb) {
          if (t < 512) gemm_tile(ALw{proj, p.mu}, p.Rw2t, 64, (t & 127) * 128, (t >> 7) * 128, 0, EPgen<decltype(fw)>{fw}, smu);
          else if (t < 1024) { int tt = t - 512; gemm_tile(ALa{proj, p.mu}, p.Ra2t, 64, (tt & 127) * 128, (tt >> 7) * 128, 0, EPgen<decltype(fa)>{fa}, smu); }
          else { int tt = t - 1024; gemm_tile(ALl{proj, p.conv_w, p.conv_b}, p.Lwt, 64, (tt & 127) * 128, (tt >> 7) * 128, tt >> 7, EPlru{proj, lab, ib, p.conv_w, p.conv_b, p.lb_a, p.lb_x, p.llam}, smu); }
        }
      } break;
      case 17: {
        if (bid < 128) rwkv_scan_job(p, bid, smem);
        else if (bid < 160) lru_scan_job(p, bid - 128, (float*)smem);
        else transpose_jobs(p.tab1, p.ntab1, p.ntiles1, (float*)smem, bid - 160, nb - 160);
      } break;
      case 18: {
        gemm_jobs(ALg{proj, p.mu}, p.Rg2t, 128, 128, 4, EPfin{proj, p.mu, p.A, p.c3buf, p.ln_g, p.ln_b}, smu, bid, nb);
      } break;
      default: break;
    }
  }
}

static inline size_t al256(size_t x) { return (x + 255) & ~(size_t)255; }

extern "C" void kernel_launch(void* const* d_in, const int* in_sizes, int n_in, void* d_out, int out_size,
                              void* d_ws, size_t ws_size, hipStream_t stream) {
  static int grid_blocks = 0;
  if (!grid_blocks) {
    int dev = 0, cus = 0, per_cu = 0;
    hipGetDevice(&dev);
    hipDeviceGetAttribute(&cus, hipDeviceAttributeMultiprocessorCount, dev);
    hipOccupancyMaxActiveBlocksPerMultiprocessor(&per_cu, mega, NTHR, 0);
    if (per_cu > 2) per_cu = 2;
    if (per_cu < 1) per_cu = 1;
    grid_blocks = cus * per_cu;
  }
  P p;
  memset(&p, 0, sizeof(p));
  const float** fin = (const float**)d_in;
  p.x = fin[0]; p.mem = fin[1]; p.norm_gain = fin[2]; p.wq = fin[3]; p.wk = fin[4]; p.wv = fin[5]; p.wo = fin[6];
  p.w1 = fin[7]; p.w2 = fin[8]; p.ab_w_in = fin[9]; p.gla_w2 = fin[10]; p.gla_bd = fin[11]; p.gla_ng = fin[12];
  p.s5_lre = fin[13]; p.s5_lim = fin[14]; p.s5_ls = fin[15]; p.s5_bre = fin[16]; p.s5_bim = fin[17]; p.s5_cre = fin[18];
  p.s5_cim = fin[19]; p.s5_d = fin[20]; p.s5_wglu = fin[21]; p.s5_bglu = fin[22]; p.ab_w_out = fin[23];
  p.cd_w_in = fin[24]; p.mu = fin[25]; p.w0 = fin[26]; p.rw2 = fin[27]; p.a0 = fin[28]; p.ra2 = fin[29]; p.rg2 = fin[30];
  p.k_k = fin[31]; p.k_a = fin[32]; p.r_k = fin[33]; p.ln_g = fin[34]; p.ln_b = fin[35]; p.conv_w = fin[36];
  p.conv_b = fin[37]; p.lw_a = fin[38]; p.lb_a = fin[39]; p.lw_x = fin[40]; p.lb_x = fin[41]; p.llam = fin[42];
  p.cd_w_out = fin[43];
  p.out = (float*)d_out;
  char* w = (char*)d_ws;
  size_t off = 0;
  auto alloc = [&](size_t bytes) { char* r = w + off; off = al256(off + bytes); return r; };
  const size_t MB = 1024 * 1024;
  p.Wq = (u16*)alloc(2 * MB); p.Wk = (u16*)alloc(2 * MB); p.Wv = (u16*)alloc(2 * MB); p.Wo = (u16*)alloc(2 * MB);
  p.W1 = (u16*)alloc(8 * MB); p.W2 = (u16*)alloc(8 * MB);
  p.Win0 = (u16*)alloc((size_t)2176 * 1024 * 2); p.Wout0 = (u16*)alloc(2 * MB); p.Wglu = (u16*)alloc(512 * 512 * 2);
  p.S5W1 = (u16*)alloc((size_t)32 * 384 * 256 * 2); p.S5W2 = (u16*)alloc((size_t)32 * 256 * 128 * 2);
  p.Win1 = (u16*)alloc((size_t)2816 * 1024 * 2); p.Wout1 = (u16*)alloc(2 * MB);
  p.Rw2t = (u16*)alloc(512 * 64 * 2); p.Ra2t = (u16*)alloc(512 * 64 * 2); p.Rg2t = (u16*)alloc(512 * 128 * 2);
  p.Lwt = (u16*)alloc(8 * 128 * 64 * 2);
  p.memn = (u16*)alloc(2 * MB); p.Kp = (u16*)alloc(2 * MB); p.Vt = (u16*)alloc(2 * MB);
  p.gdec = (float*)alloc(16 * 64 * 64 * 4);
  p.c3buf = (float*)alloc((size_t)T_TOK * 8 * 4);
  p.bar = (unsigned*)alloc(XCD_BAR_WORDS * 4);
  p.A = (u16*)alloc(32 * MB); p.B = (u16*)alloc(32 * MB);
  p.H = alloc((size_t)T_TOK * PROJ0_LD * 2 + 64 * MB);
  if (off > ws_size) { fprintf(stderr, "workspace too small: need %zu have %zu\n", off, ws_size); }
  int nt = 0, tiles = 0;
  auto add = [&](TDesc* tab, const float* src, u16* dst, int K, int N, int Npad) {
    tab[nt].src = src; tab[nt].dst = dst; tab[nt].K = K; tab[nt].N = N; tab[nt].Npad = Npad; tab[nt].t0 = tiles;
    tiles += (K / 64) * (Npad / 64); nt++;
  };
  add(p.tab0, p.ab_w_in, p.Win0, 1024, 2064, 2176);
  add(p.tab0, p.w1, p.W1, 1024, 4096, 4096);
  add(p.tab0, p.w2, p.W2, 4096, 1024, 1024);
  add(p.tab0, p.wq, p.Wq, 1024, 1024, 1024);
  add(p.tab0, p.wk, p.Wk, 1024, 1024, 1024);
  add(p.tab0, p.wv, p.Wv, 1024, 1024, 1024);
  add(p.tab0, p.wo, p.Wo, 1024, 1024, 1024);
  add(p.tab0, p.ab_w_out, p.Wout0, 1024, 1024, 1024);
  add(p.tab0, p.s5_wglu, p.Wglu, 512, 512, 512);
  add(p.tab0, p.cd_w_in, p.Win1, 1024, 2816, 2816);
  add(p.tab0, p.cd_w_out, p.Wout1, 1024, 1024, 1024);
  add(p.tab0, p.rw2, p.Rw2t, 64, 512, 512);
  add(p.tab0, p.ra2, p.Ra2t, 64, 512, 512);
  add(p.tab0, p.rg2, p.Rg2t, 128, 512, 512);
  p.ntab0 = nt; p.ntiles0 = tiles;
  nt = 0; tiles = 0;
  add(p.tab1, p.w1 + (size_t)1024 * 4096, p.W1, 1024, 4096, 4096);
  add(p.tab1, p.w2 + (size_t)1024 * 4096, p.W2, 4096, 1024, 1024);
  add(p.tab1, p.wq + MB, p.Wq, 1024, 1024, 1024);
  add(p.tab1, p.wk + MB, p.Wk, 1024, 1024, 1024);
  add(p.tab1, p.wv + MB, p.Wv, 1024, 1024, 1024);
  add(p.tab1, p.wo + MB, p.Wo, 1024, 1024, 1024);
  p.ntab1 = nt; p.ntiles1 = tiles;

#ifdef MULTI_LAUNCH
  for (int ph = 0; ph < 28; ph++) {
    int lo = ph, hi = ph + 1;
    hipLaunchKernelGGL(mega, dim3(grid_blocks), dim3(NTHR), 0, stream, p, lo, hi);
  }
#else
  {
    int n = 0;
    for (int ph = 0; ph < 28; ph++) {
      p.seq[n++] = (unsigned char)ph;
#ifdef PROBE_MASK
      if ((PROBE_MASK >> ph) & 1u) p.seq[n++] = (unsigned char)ph;
#endif
    }
    p.nseq = n;
  }
  int lo = 0, hi = p.nseq;
  void* args[] = {&p, &lo, &hi};
  hipError_t e = hipLaunchCooperativeKernel((void*)mega, dim3(grid_blocks), dim3(NTHR), args, 0, stream);
  if (e != hipSuccess) fprintf(stderr, "coop launch failed: %s (grid %d)\n", hipGetErrorString(e), grid_blocks);
#endif
}
```
